# Optimizing an MI355X kernel written in HIP

```python
import math
import jax, jax.numpy as jnp
from jax import lax
import numpy as np

D_MODEL = 4096
BATCH = 1
SEQ = 8192
DEPTH = 2
DEC_BATCH = 8
DEC_SEQ = 16
PAST_LEN = 1024

CHUNK = 64
N_MIXERS = 2
N_POOL_LAYERS = (DEPTH + 1) // 2
N_SSM_LAYERS = DEPTH // 2
POOL_WINDOWS = (2, 4, 8, 16)
N_POOL_GROUPS = len(POOL_WINDOWS)
POOL_GROUP = D_MODEL // N_POOL_GROUPS
POOL_HIST = max(POOL_WINDOWS) - 1
SSM_GROUP = 16
N_SSM_GROUPS = D_MODEL // SSM_GROUP
SSM_STATE = 64
D_FF = 4 * D_MODEL
EPS = 1e-6
DT_MIN = 1e-3
DT_MAX = 1e-1

kernel_name = "hybrid_pool_s5_streaming_step"


def rmsnorm(x, g):
    xf = x.astype(jnp.float32)
    y = xf * lax.rsqrt(jnp.mean(xf * xf, axis=-1, keepdims=True) + EPS) * g.astype(jnp.float32)
    return y.astype(x.dtype)


def pool_mixer(u, hist, pos0, w_pool, scale):
    b, L, _ = u.shape
    ext = jnp.concatenate([hist.astype(u.dtype), u], axis=1)
    cs = jnp.cumsum(jnp.pad(ext.astype(jnp.float32), ((0, 0), (1, 0), (0, 0))), axis=1)
    end = cs[:, POOL_HIST + 1:POOL_HIST + 1 + L]
    pos = pos0 + jnp.arange(L, dtype=jnp.int32)
    means = []
    for gi, w in enumerate(POOL_WINDOWS):
        sl = slice(gi * POOL_GROUP, (gi + 1) * POOL_GROUP)
        start = cs[:, POOL_HIST + 1 - w:POOL_HIST + 1 - w + L, sl]
        cnt = jnp.minimum(w, pos + 1).astype(jnp.float32)[None, :, None]
        means.append((end[..., sl] - start) / cnt)
    pooled = jnp.concatenate(means, axis=-1) - u.astype(jnp.float32)
    mixed = jnp.einsum('blgc,gcd->blgd', pooled.reshape(b, L, N_POOL_GROUPS, POOL_GROUP),
                       w_pool.astype(jnp.float32)).reshape(b, L, D_MODEL)
    out = (mixed * scale.astype(jnp.float32)).astype(u.dtype)
    new_hist = ext[:, -POOL_HIST:]
    return out, new_hist


def _ssm_combine(left, right):
    a_l, b_l = left
    a_r, b_r = right
    return a_r * a_l, a_r * b_l + b_r


def ssm_mixer(u, h0_re, h0_im, a_re, a_im, log_dt, b_re, b_im, c_re, c_im, d_skip, w_glu_a, w_glu_b):
    b, L, _ = u.shape
    f32 = jnp.float32
    lam = lax.complex(a_re.astype(f32), a_im.astype(f32))
    dt = jnp.exp(log_dt.astype(f32))[:, None]
    a_bar = jnp.exp(lam * dt)
    b_bar = ((a_bar - 1.0) / lam)[..., None] * lax.complex(b_re.astype(f32), b_im.astype(f32))
    uf = u.astype(f32)
    ug = uf.reshape(b, L, N_SSM_GROUPS, SSM_GROUP).astype(jnp.complex64)
    bu = jnp.einsum('gpc,blgc->blgp', b_bar, ug)
    a_seq = jnp.broadcast_to(a_bar, bu.shape)
    a_cum, h = lax.associative_scan(_ssm_combine, (a_seq, bu), axis=1)
    h0 = lax.complex(h0_re.astype(f32), h0_im.astype(f32))
    h = h + a_cum * h0[:, None]
    c = lax.complex(c_re.astype(f32), c_im.astype(f32))
    y = jnp.real(jnp.einsum('gcp,blgp->blgc', c, h)).reshape(b, L, D_MODEL) + d_skip.astype(f32) * uf
    y = jax.nn.gelu(y)
    out = jnp.matmul(y, w_glu_a.astype(f32)) * jax.nn.sigmoid(jnp.matmul(y, w_glu_b.astype(f32)))
    h_last = h[:, -1]
    return out.astype(u.dtype), jnp.real(h_last), jnp.imag(h_last)


def sq_relu_mlp(x, w_up, w_down):
    h = jnp.square(jax.nn.relu(jnp.matmul(x, w_up)))
    return jnp.matmul(h, w_down)


def trunk(x, pool_hist, h0_re, h0_im, pos0, norm_mix, w_pool, pool_scale, ssm_a_re, ssm_a_im,
          ssm_log_dt, ssm_b_re, ssm_b_im, ssm_c_re, ssm_c_im, ssm_d, w_glu_a, w_glu_b,
          norm_ffn, w_up, w_down, norm_final):
    pool_new, ssm_re_new, ssm_im_new = [], [], []
    pi, si = 0, 0
    for layer in range(DEPTH):
        xn = rmsnorm(x, norm_mix[layer])
        if layer % N_MIXERS == 0:
            out, nh = pool_mixer(xn, pool_hist[pi], pos0, w_pool[pi], pool_scale[pi])
            pool_new.append(nh)
            pi += 1
        else:
            out, hr, hi = ssm_mixer(xn, h0_re[si], h0_im[si], ssm_a_re[si], ssm_a_im[si], ssm_log_dt[si],
                                    ssm_b_re[si], ssm_b_im[si], ssm_c_re[si], ssm_c_im[si], ssm_d[si],
                                    w_glu_a[si], w_glu_b[si])
            ssm_re_new.append(hr)
            ssm_im_new.append(hi)
            si += 1
        x = x + out
        x = x + sq_relu_mlp(rmsnorm(x, norm_ffn[layer]), w_up[layer], w_down[layer])
    y = rmsnorm(x, norm_final)
    return y, jnp.stack(pool_new), jnp.stack(ssm_re_new), jnp.stack(ssm_im_new)


def setup_inputs(seed: int = 0) -> dict:
    key = jax.random.key(seed)
    ks = jax.random.split(key, 24)
    f32 = jnp.float32
    G, P, C = N_SSM_GROUPS, SSM_STATE, SSM_GROUP
    nrm = lambda k, s: jax.random.normal(k, s, f32)
    x_prompt = nrm(ks[0], (BATCH, SEQ, D_MODEL))
    x_sample = nrm(ks[1], (DEC_BATCH, DEC_SEQ, D_MODEL))
    cache_pool = nrm(ks[2], (N_POOL_LAYERS, DEC_BATCH, POOL_HIST, D_MODEL))
    state_ssm_re = 0.1 * nrm(ks[3], (N_SSM_LAYERS, DEC_BATCH, G, P))
    state_ssm_im = 0.1 * nrm(ks[4], (N_SSM_LAYERS, DEC_BATCH, G, P))
    norm_mix = 1.0 + 0.01 * nrm(ks[5], (DEPTH, D_MODEL))
    w_pool = nrm(ks[6], (N_POOL_LAYERS, N_POOL_GROUPS, POOL_GROUP, POOL_GROUP)) * POOL_GROUP ** -0.5
    pool_scale = 1.0 + 0.01 * nrm(ks[7], (N_POOL_LAYERS, D_MODEL))
    ssm_a_re = -0.5 + 0.01 * nrm(ks[8], (N_SSM_LAYERS, G, P))
    ssm_a_im = math.pi * jnp.arange(P, dtype=f32)[None, None, :] + 0.01 * nrm(ks[9], (N_SSM_LAYERS, G, P))
    ssm_log_dt = jax.random.uniform(ks[10], (N_SSM_LAYERS, G), f32, math.log(DT_MIN), math.log(DT_MAX))
    ssm_b_re = nrm(ks[11], (N_SSM_LAYERS, G, P, C)) * (2.0 * C) ** -0.5
    ssm_b_im = nrm(ks[12], (N_SSM_LAYERS, G, P, C)) * (2.0 * C) ** -0.5
    ssm_c_re = nrm(ks[13], (N_SSM_LAYERS, G, C, P)) * (2.0 * P) ** -0.5
    ssm_c_im = nrm(ks[14], (N_SSM_LAYERS, G, C, P)) * (2.0 * P) ** -0.5
    ssm_d = nrm(ks[15], (N_SSM_LAYERS, D_MODEL))
    w_glu_a = nrm(ks[16], (N_SSM_LAYERS, D_MODEL, D_MODEL)) * D_MODEL ** -0.5
    w_glu_b = nrm(ks[17], (N_SSM_LAYERS, D_MODEL, D_MODEL)) * D_MODEL ** -0.5
    norm_ffn = 1.0 + 0.01 * nrm(ks[18], (DEPTH, D_MODEL))
    w_up = nrm(ks[19], (DEPTH, D_MODEL, D_FF)) * D_MODEL ** -0.5
    w_down = nrm(ks[20], (DEPTH, D_FF, D_MODEL)) * D_FF ** -0.5
    norm_final = 1.0 + 0.01 * nrm(ks[21], (D_MODEL,))
    return {"x_prompt": x_prompt, "x_sample": x_sample, "cache_pool": cache_pool,
            "state_ssm_re": state_ssm_re, "state_ssm_im": state_ssm_im,
            "norm_mix": norm_mix, "w_pool": w_pool, "pool_scale": pool_scale,
            "ssm_a_re": ssm_a_re, "ssm_a_im": ssm_a_im, "ssm_log_dt": ssm_log_dt,
            "ssm_b_re": ssm_b_re, "ssm_b_im": ssm_b_im, "ssm_c_re": ssm_c_re, "ssm_c_im": ssm_c_im,
            "ssm_d": ssm_d, "w_glu_a": w_glu_a, "w_glu_b": w_glu_b,
            "norm_ffn": norm_ffn, "w_up": w_up, "w_down": w_down, "norm_final": norm_final}


def reference(x_prompt, x_sample, cache_pool, state_ssm_re, state_ssm_im, norm_mix, w_pool, pool_scale,
              ssm_a_re, ssm_a_im, ssm_log_dt, ssm_b_re, ssm_b_im, ssm_c_re, ssm_c_im, ssm_d,
              w_glu_a, w_glu_b, norm_ffn, w_up, w_down, norm_final):
    weights = (norm_mix, w_pool, pool_scale, ssm_a_re, ssm_a_im, ssm_log_dt, ssm_b_re, ssm_b_im,
               ssm_c_re, ssm_c_im, ssm_d, w_glu_a, w_glu_b, norm_ffn, w_up, w_down, norm_final)
    b_p = x_prompt.shape[0]
    zero_hist = jnp.zeros((N_POOL_LAYERS, b_p, POOL_HIST, D_MODEL), x_prompt.dtype)
    zero_h = jnp.zeros((N_SSM_LAYERS, b_p, N_SSM_GROUPS, SSM_STATE), jnp.float32)
    y_prompt, pool_rows_p, ssm_re_p, ssm_im_p = trunk(x_prompt, zero_hist, zero_h, zero_h, 0, *weights)
    y_sample, pool_rows_s, ssm_re_s, ssm_im_s = trunk(x_sample, cache_pool, state_ssm_re, state_ssm_im,
                                                      PAST_LEN, *weights)
    return (y_prompt, y_sample, pool_rows_p, pool_rows_s, ssm_re_p, ssm_im_p, ssm_re_s, ssm_im_s)
```

```cpp
#include <hip/hip_runtime.h>
#include <cstdio>
#include <cstdint>

#define LAS __attribute__((address_space(3)))
#define GAS __attribute__((address_space(1)))
typedef unsigned short bf16_t;
typedef short bf16x8 __attribute__((ext_vector_type(8)));
typedef float f32x4 __attribute__((ext_vector_type(4)));
typedef float f32x2 __attribute__((ext_vector_type(2)));
typedef unsigned u32x4 __attribute__((ext_vector_type(4)));
typedef unsigned u32x2 __attribute__((ext_vector_type(2)));

constexpr int DM = 4096, DFF = 16384, SEQ = 8192, NB = 8, LS = 16, NSAMP = NB * LS, MROWS = SEQ + NSAMP;
constexpr int NGRP = 256, PST = 64, CG = 16;
constexpr int NCHUNK = MROWS / 16;
constexpr int NCHP = 528;
constexpr float EPS = 1e-6f;
constexpr int NWAVES = 8;
#ifndef MK_N_LAUNCHES
#define MK_N_LAUNCHES 1
#endif
constexpr int NPHASE = 14;
#ifndef REP_CONV
#define REP_CONV 1
#endif
#ifndef REP_POOL
#define REP_POOL 1
#endif
#ifndef REP_SSM
#define REP_SSM 1
#endif
#ifndef REP_UP
#define REP_UP 1
#endif
constexpr int N_LAUNCHES = MK_N_LAUNCHES;

constexpr size_t O_YP = 0, O_YS = 33554432, O_PRP = 34078720, O_PRS = 34140160, O_SRP = 34631680, O_SIP = 34648064, O_SRS = 34664448, O_SIS = 34795520, O_END = 34926592;

constexpr size_t MiB = 1u << 20;
constexpr size_t WS_CTL = 0, CTL_ZERO_BYTES = 1 * MiB;
constexpr size_t WS_SS = 512 * 1024;
constexpr size_t WS_WPOOL = 2 * MiB, WS_WGLU = 10 * MiB, WS_WUP0 = 74 * MiB, WS_WUP1 = 202 * MiB, WS_WDN0 = 330 * MiB, WS_WDN1 = 458 * MiB;
constexpr size_t WS_X = 586 * MiB, WS_A0 = 716 * MiB, WS_A1 = 781 * MiB, WS_H = 847 * MiB, WS_SG = 1111 * MiB, WS_HG = 1177 * MiB, WS_SLAB = 1210 * MiB, WS_END = 1242 * MiB;
static_assert((size_t)MROWS * DM * 4 == 130 * MiB && (size_t)MROWS * DM * 2 == 65 * MiB && (size_t)MROWS * DFF * 2 == 260 * MiB, "buffer sizes");
static_assert((size_t)NGRP * NCHP * 128 * 4 == 66 * MiB && (size_t)NGRP * NCHP * 128 * 2 == 33 * MiB, "ssm scratch sizes");
constexpr int CW_BAR = 4096;

constexpr int RING_BYTES = 131072, LDS_BYTES = 163840, LDSCTL_OFF = LDS_BYTES - 512, MISC_OFF = LDSCTL_OFF + 320;

__device__ __forceinline__ unsigned f2bf(float f) { unsigned u = __builtin_bit_cast(unsigned, f); return (u + 0x7fffu + ((u >> 16) & 1u)) >> 16; }
__device__ __forceinline__ unsigned pk2(float lo, float hi) { return f2bf(lo) | (f2bf(hi) << 16); }
__device__ __forceinline__ unsigned cvt_pk_bf16(float lo, float hi) { unsigned r; asm volatile("v_cvt_pk_bf16_f32 %0, %1, %2" : "=v"(r) : "v"(lo), "v"(hi)); return r; }
typedef __bf16 bf16x2_t __attribute__((ext_vector_type(2)));
__device__ __forceinline__ unsigned cvt_pk_bf16_c(float lo, float hi) { return __builtin_bit_cast(unsigned, __builtin_convertvector((f32x2){lo, hi}, bf16x2_t)); }
__device__ __forceinline__ float bf_lo(unsigned w) { return __builtin_bit_cast(float, w << 16); }
__device__ __forceinline__ float bf_hi(unsigned w) { return __builtin_bit_cast(float, w & 0xffff0000u); }

namespace pg8 {
constexpr int BM = 256, BK = 64, HALF = 128, HTB = HALF * BK * 2, STAGE_BYTES = 8 * HTB;
__host__ __device__ __forceinline__ int lds_byte(int r, int c) { const int st = (r >> 4) * 2 + (c >> 5), rr = r & 15, cc = c & 31, ob = rr * 64 + cc * 2; return st * 1024 + (ob ^ (((ob >> 9) & 1) << 5)); }
__host__ __device__ __forceinline__ void stage_rc(int b, int& R, int& C) { const int st = b / 1024, sb = b % 1024, swz = sb ^ (((sb >> 9) & 1) << 5); R = (st >> 1) * 16 + swz / 64; C = (st & 1) * 32 + (swz % 64) / 2; }
__host__ __device__ __forceinline__ int perm32(int rho) { const int n = rho >> 4, i = rho & 15; return 8 * (i >> 2) + 4 * n + (i & 3); }

struct Unit { int pm, pn, kind, ks; };
struct Gemm {
    const char* A; const char* Bt;
    unsigned a_rs, a_gs, b_rs;
    int nt_full, nt_split;
    int a_kgrp_pn4;
    unsigned a_ts;
};
struct Sched {
    int nN, G, c, nsplit, nwg;
    __device__ __forceinline__ void init(int nN_, int G_, int c_, int nsplit_) { nN = nN_; G = G_; c = c_; nsplit = nsplit_; nwg = 32 * nN_; }
    __device__ __forceinline__ bool next(int i, Unit& u) const {
        const long L = (long)i * G + c;
        const bool prompt = L < nwg;
        int wgid = prompt ? (int)L : 0; { const int q = nwg / 8, xcd = wgid % 8, off = wgid / 8; wgid = xcd * q + off; }
        const int nig = 8 * nN, gid = wgid / nig, fm = gid * 8;
        const int s = prompt ? 0 : (int)(L - nwg);
        const int pm_ = prompt ? fm + ((wgid % nig) % 8) : 32, pn_ = prompt ? (wgid % nig) / 8 : s / nsplit, kind_ = prompt ? 0 : 1, ks_ = prompt ? 0 : s % nsplit;
        u.pm = pm_; u.pn = pn_; u.kind = kind_; u.ks = ks_;
        return prompt || (L - nwg) < (long)nN * nsplit;
    }
};

template <class Epi>
__device__ __forceinline__ void gemm_phase(LAS unsigned char* lds, const Gemm g, const Sched& S, const Epi& E) {
    const int tid = threadIdx.x, wid = __builtin_amdgcn_readfirstlane(tid >> 6), lane = tid & 63, wr = wid >> 2, wc = wid & 3, fr = lane & 15, fq = lane >> 4;
    unsigned voffA[2], voffB[2];
#pragma unroll
    for (int i = 0; i < 2; ++i) { int R, C; stage_rc(tid * 16 + i * 8192, R, C); const int Rb = Epi::PERM ? ((R & ~31) + perm32(R & 31)) : R;
        voffA[i] = g.a_rs ? (unsigned)R * g.a_rs + (unsigned)(C >> 4) * g.a_gs + (unsigned)(C & 15) * 2u : (unsigned)(tid * 16 + i * 8192); voffB[i] = (unsigned)(tid * 16 + i * 8192); (void)Rb; }
    const size_t akstep = (size_t)g.a_gs * 4, bkstep = (size_t)(2 * HTB);
    const size_t ahstep = g.a_rs ? (size_t)HALF * g.a_rs : (size_t)HTB, bhstep = (size_t)HTB;
    const size_t atstep = g.a_rs ? 2 * ahstep : (size_t)g.a_ts, btstep = (size_t)256 * g.b_rs;
    const unsigned ldsw = (unsigned)wid * 1024u;
    const int aoff = lds_byte(wr * 64 + fr, fq * 8), boff = lds_byte(wc * 32 + fr, fq * 8);
#define PG8_SA(b, h) (((b) * 2 + (h)) * HTB)
#define PG8_SB(b, h) ((4 + (b) * 2 + (h)) * HTB)
#define PG8_STAGE(bufoff, gbase, voff) do { _Pragma("unroll") for (int _i = 0; _i < 2; ++_i) \
        __builtin_amdgcn_global_load_lds((const unsigned*)((const char*)(gbase) + (voff)[_i]), (LAS unsigned*)(lds + (bufoff) + ldsw + _i * 8192), 16, 0, 0); } while (0)
#define PG8_LDA(dst, b, h) do { _Pragma("unroll") for (int m = 0; m < 4; ++m) _Pragma("unroll") for (int k = 0; k < 2; ++k) dst[m][k] = *(const LAS bf16x8*)(lds + PG8_SA(b, h) + aoff + m * 2048 + k * 1024); } while (0)
#define PG8_LDB(dst, b, h) do { _Pragma("unroll") for (int n = 0; n < 2; ++n) _Pragma("unroll") for (int k = 0; k < 2; ++k) dst[n][k] = *(const LAS bf16x8*)(lds + PG8_SB(b, h) + boff + n * 2048 + k * 1024); } while (0)
#define PG8_MMA(ai, bj, At, Bt) do { __builtin_amdgcn_s_setprio(1); _Pragma("unroll") for (int m = 0; m < 4; ++m) _Pragma("unroll") for (int n = 0; n < 2; ++n) _Pragma("unroll") for (int k = 0; k < 2; ++k) \
        acc[ai][bj][m][n] = __builtin_amdgcn_mfma_f32_16x16x32_bf16(Bt[n][k], At[m][k], acc[ai][bj][m][n], 0, 0, 0); __builtin_amdgcn_s_setprio(0); } while (0)
#define PG8_WAIT_V(n) asm volatile("s_waitcnt vmcnt(" #n ")" ::: "memory")
#define PG8_WAIT_L(n) asm volatile("s_waitcnt lgkmcnt(" #n ")" ::: "memory")
#define PG8_BAR __builtin_amdgcn_s_barrier()
#define PG8_SCHED __builtin_amdgcn_sched_barrier(0)
#define PG8_UNIT_PTRS(u, pA, pB, hs, ntu) do { const int _nt = (u).kind ? g.nt_split : g.nt_full; \
        pA = g.A + (size_t)(u).pm * atstep + ((size_t)((u).pn >> 2) * g.a_kgrp_pn4 + (size_t)(u).ks * _nt * 4) * g.a_gs; \
        pB = g.Bt + (size_t)(u).pn * btstep + (size_t)(u).ks * _nt * bkstep; hs = (u).kind ? (size_t)0 : ahstep; ntu = _nt; } while (0)
    Unit cur, nxt; int ui = 0; bool st16 = false;
    if (!S.next(0, cur)) return;
    f32x4 acc[2][2][4][2];
#pragma unroll
    for (int a = 0; a < 2; ++a)
#pragma unroll
        for (int b = 0; b < 2; ++b)
#pragma unroll
            for (int m = 0; m < 4; ++m)
#pragma unroll
                for (int n = 0; n < 2; ++n) acc[a][b][m][n] = (f32x4){0.f, 0.f, 0.f, 0.f};
    bf16x8 At[4][2], B0[2][2], B1[2][2];
    const char* cA; const char* cB; size_t cH; int nt;
    PG8_UNIT_PTRS(cur, cA, cB, cH, nt);
    PG8_STAGE(PG8_SB(0, 0), cB, voffB); PG8_STAGE(PG8_SB(0, 1), cB + bhstep, voffB); PG8_STAGE(PG8_SA(0, 0), cA, voffA); PG8_STAGE(PG8_SA(0, 1), cA + cH, voffA);
    if (wr == 1) PG8_BAR;
    PG8_WAIT_V(2); PG8_BAR;
    PG8_STAGE(PG8_SB(1, 0), cB + bkstep, voffB); PG8_STAGE(PG8_SA(1, 0), cA + akstep, voffA); PG8_STAGE(PG8_SB(1, 1), cB + bhstep + bkstep, voffB);
    PG8_WAIT_V(6); PG8_BAR;
    for (;;) {
        const bool has_next = S.next(ui + 1, nxt);
        const char* nA = cA; const char* nB = cB; size_t nH = cH; int nnt = nt;
        if (has_next) PG8_UNIT_PTRS(nxt, nA, nB, nH, nnt);
#define PG8_ITER(FULL, W1, W2) { \
            const bool last = (t == nt - 2); \
            const char* a1 = cA + (size_t)(t + 1) * akstep; \
            const char* a2 = last ? nA : cA + (size_t)(t + 2) * akstep; const char* b2 = last ? nB : cB + (size_t)(t + 2) * bkstep; \
            const size_t h2 = last ? nH : cH; \
            const char* a3 = a2 + akstep; const char* b3 = b2 + bkstep; \
              \
            PG8_LDB(B0, 0, 0); PG8_LDB(B1, 0, 1); PG8_SCHED; PG8_LDA(At, 0, 0); PG8_STAGE(PG8_SA(1, 1), a1 + cH, voffA); \
            PG8_WAIT_V(W1); PG8_WAIT_L(0); PG8_BAR; PG8_MMA(0, 0, At, B0); PG8_MMA(0, 1, At, B1); PG8_BAR; PG8_SCHED; \
              \
            if (FULL) PG8_LDA(At, 0, 1); PG8_STAGE(PG8_SB(0, 0), b2, voffB); PG8_STAGE(PG8_SB(0, 1), b2 + bhstep, voffB); PG8_STAGE(PG8_SA(0, 0), a2, voffA); \
            PG8_WAIT_V(W2); PG8_WAIT_L(0); PG8_BAR; if (FULL) { PG8_MMA(1, 0, At, B0); PG8_MMA(1, 1, At, B1); } PG8_BAR; PG8_SCHED; \
              \
            PG8_LDB(B0, 1, 0); PG8_LDB(B1, 1, 1); PG8_SCHED; PG8_LDA(At, 1, 0); PG8_STAGE(PG8_SA(0, 1), a2 + h2, voffA); \
            PG8_WAIT_V(8); PG8_WAIT_L(0); PG8_BAR; PG8_MMA(0, 0, At, B0); PG8_MMA(0, 1, At, B1); PG8_BAR; PG8_SCHED; \
              \
            if (FULL) PG8_LDA(At, 1, 1); PG8_STAGE(PG8_SB(1, 0), b3, voffB); PG8_STAGE(PG8_SB(1, 1), b3 + bhstep, voffB); PG8_STAGE(PG8_SA(1, 0), a3, voffA); \
            PG8_WAIT_V(8); PG8_WAIT_L(0); PG8_BAR; if (FULL) { PG8_MMA(1, 0, At, B0); PG8_MMA(1, 1, At, B1); } PG8_BAR; PG8_SCHED; }
#define PG8_KLOOP(FULL) { for (int t = 0; t < nt; t += 2) PG8_ITER(FULL, 8, 8) }
        if (cur.kind == 0) PG8_KLOOP(true) else PG8_KLOOP(false)
#undef PG8_KLOOP
#undef PG8_ITER
        if (wr == 0) PG8_BAR;
        E(acc, cur, wr, wc, fr, fq);
        if (!has_next) break;
#pragma unroll
        for (int a = 0; a < 2; ++a)
#pragma unroll
            for (int b = 0; b < 2; ++b)
#pragma unroll
                for (int m = 0; m < 4; ++m)
#pragma unroll
                    for (int n = 0; n < 2; ++n) acc[a][b][m][n] = (f32x4){0.f, 0.f, 0.f, 0.f};
        st16 = Epi::ST16 || cur.kind != 0;
        cur = nxt; cA = nA; cB = nB; cH = nH; nt = nnt; ++ui;
        if (wr == 1) PG8_BAR;
    }
    PG8_WAIT_V(0);
    PG8_BAR;
#undef PG8_SA
#undef PG8_SB
#undef PG8_STAGE
#undef PG8_LDA
#undef PG8_LDB
#undef PG8_MMA
#undef PG8_WAIT_V
#undef PG8_WAIT_L
#undef PG8_BAR
#undef PG8_SCHED
#undef PG8_UNIT_PTRS
}
}

__device__ __forceinline__ size_t tiled_off(int row, int col, int nkt) { return (((size_t)(row >> 8) * nkt + (col >> 6)) * 2 + ((row >> 7) & 1)) * (size_t)pg8::HTB + pg8::lds_byte(row & 127, col & 63); }
struct EpiArgs {
    const float* xin_p; const float* xin_s; const bf16_t* Rin; bf16_t* Aout; bf16_t* H; float* outy; const float* vec; const float* ss_in; float* ss_out; bf16_t* slab; int slab_ld;
};
__device__ __forceinline__ float sigmoidf_(float x) { return __builtin_amdgcn_rcpf(1.0f + __expf(-x)); }
template <int MODE> struct Epi {
    static constexpr bool PERM = true, ST16 = (MODE == 2);
    EpiArgs a;
    __device__ __forceinline__ void operator()(const f32x4 (&acc)[2][2][4][2], const pg8::Unit& u, int wr, int wc, int fr, int fq) const {
        const int colb = u.pn * 256 + wc * 32 + 8 * fq;
        if (u.kind != 0) {
            bf16_t* sl = a.slab + (size_t)u.ks * NSAMP * a.slab_ld + colb;
#pragma unroll
            for (int m = 0; m < 4; ++m) { bf16_t* rp = sl + (size_t)(wr * 64 + m * 16 + fr) * a.slab_ld;
#pragma unroll
                for (int bj = 0; bj < 2; ++bj) { const f32x4 v0 = acc[0][bj][m][0], v1 = acc[0][bj][m][1];
                    u32x4 w; w.x = cvt_pk_bf16_c(v0[0], v0[1]); w.y = cvt_pk_bf16_c(v0[2], v0[3]); w.z = cvt_pk_bf16_c(v1[0], v1[1]); w.w = cvt_pk_bf16_c(v1[2], v1[3]);
                    *(u32x4*)(rp + 128 * bj) = w; } }
            return;
        }
#define SSQ8(v0, v1) ((v0[0] * v0[0] + v0[1] * v0[1]) + (v0[2] * v0[2] + v0[3] * v0[3]) + (v1[0] * v1[0] + v1[1] * v1[1]) + (v1[2] * v1[2] + v1[3] * v1[3]))
        float rs8[2][4];
        if constexpr (MODE == 2) {
#pragma unroll
            for (int ai = 0; ai < 2; ++ai)
#pragma unroll
                for (int m = 0; m < 4; ++m) rs8[ai][m] = a.ss_in[u.pm * 256 + ai * 128 + wr * 64 + fr + 16 * m]; }
#pragma unroll
        for (int ai = 0; ai < 2; ++ai) {
            const int gr0 = u.pm * 256 + ai * 128 + wr * 64 + fr;
            if constexpr (MODE == 2) {
#pragma unroll
                for (int m = 0; m < 4; ++m) { const float r = __builtin_amdgcn_rsqf(rs8[ai][m] * (1.0f / DM) + EPS);
#pragma unroll
                    for (int bj = 0; bj < 2; ++bj) { const int col = colb + 128 * bj;
                        const f32x4 z4 = (f32x4){0.f, 0.f, 0.f, 0.f};
                        const f32x4 p0 = __builtin_elementwise_max(acc[ai][bj][m][0], z4) * r, p1 = __builtin_elementwise_max(acc[ai][bj][m][1], z4) * r;
                        const f32x4 v0 = p0 * p0, v1 = p1 * p1;
                        u32x4 w; w.x = cvt_pk_bf16(v0[0], v0[1]); w.y = cvt_pk_bf16(v0[2], v0[3]); w.z = cvt_pk_bf16(v1[0], v1[1]); w.w = cvt_pk_bf16(v1[2], v1[3]);
                        *(u32x4*)((char*)a.H + tiled_off(gr0 + 16 * m, col, DFF / 64)) = w; } }
            } else {
                const int col4 = u.pn * 128 + wc * 32 + 8 * fq;
                f32x4 vs[2][2];
                if constexpr (MODE == 1) {
#pragma unroll
                    for (int bj = 0; bj < 2; ++bj) { vs[bj][0] = *(const f32x4*)(a.vec + colb + 128 * bj); vs[bj][1] = *(const f32x4*)(a.vec + colb + 128 * bj + 4); } }
                constexpr int NBJ = (MODE == 4) ? 1 : 2;
                constexpr int MB = (MODE == 1) ? 2 : 4;
#pragma unroll
                for (int mh = 0; mh < 4 / MB; ++mh) {
                    f32x4 xf[MODE == 1 ? MB : 1][2][2]; u32x4 xr4[MODE == 1 ? 1 : MB][NBJ];
#pragma unroll
                    for (int mm = 0; mm < MB; ++mm) { const int gr = gr0 + 16 * (MB * mh + mm);
#pragma unroll
                        for (int bj = 0; bj < NBJ; ++bj) {
                            if constexpr (MODE == 1) { const float* xr = ((gr < SEQ) ? a.xin_p + (size_t)gr * DM : a.xin_s + (size_t)(gr - SEQ) * DM) + colb + 128 * bj; xf[mm][bj][0] = *(const f32x4*)xr; xf[mm][bj][1] = *(const f32x4*)(xr + 4); }
                            else { const int col = (MODE == 4) ? col4 : colb + 128 * bj;
                                xr4[mm][bj] = (MODE == 4) ? *(const u32x4*)(a.Rin + ((size_t)(col >> 4) * MROWS + gr) * 16 + (col & 15)) : *(const u32x4*)((const char*)a.Rin + tiled_off(gr, col, DM / 64)); } } }
#pragma unroll
                    for (int mm = 0; mm < MB; ++mm) { const int m = MB * mh + mm, gr = gr0 + 16 * m; float ss = 0.f;
#pragma unroll
                        for (int bj = 0; bj < NBJ; ++bj) { const int col = (MODE == 4) ? col4 : colb + 128 * bj;
                            f32x4 v0, v1;
                            if constexpr (MODE == 1) { v0 = xf[mm][bj][0] + vs[bj][0] * acc[ai][bj][m][0]; v1 = xf[mm][bj][1] + vs[bj][1] * acc[ai][bj][m][1]; }
                            else { const u32x4 rw = xr4[mm][bj]; v0 = (f32x4){bf_lo(rw.x), bf_hi(rw.x), bf_lo(rw.y), bf_hi(rw.y)}; v1 = (f32x4){bf_lo(rw.z), bf_hi(rw.z), bf_lo(rw.w), bf_hi(rw.w)};
                                if constexpr (MODE == 4) {
#pragma unroll
                                    for (int j = 0; j < 4; ++j) { v0[j] += acc[ai][0][m][0][j] * sigmoidf_(acc[ai][1][m][0][j]); v1[j] += acc[ai][0][m][1][j] * sigmoidf_(acc[ai][1][m][1][j]); } }
                                else { v0 += acc[ai][bj][m][0]; v1 += acc[ai][bj][m][1]; } }
                            ss += SSQ8(v0, v1);
                            u32x4 w; w.x = cvt_pk_bf16(v0[0], v0[1]); w.y = cvt_pk_bf16(v0[2], v0[3]); w.z = cvt_pk_bf16(v1[0], v1[1]); w.w = cvt_pk_bf16(v1[2], v1[3]);
                            if constexpr (MODE == 3) *(u32x4*)(a.Aout + ((size_t)(col >> 4) * MROWS + gr) * 16 + (col & 15)) = w;
                            else if constexpr (MODE == 5) *(u32x4*)(a.Aout + (size_t)gr * DM + col) = w;
                            else *(u32x4*)((char*)a.Aout + tiled_off(gr, col, DM / 64)) = w;
                        }
                        ss += __shfl_xor(ss, 16); ss += __shfl_xor(ss, 32);
                        if (fq == 0) unsafeAtomicAdd(a.ss_out + gr, ss); }
                }
            }
        }
#undef SSQ8
    }
};

typedef GAS unsigned gu32;
#define RLX_AGENT __ATOMIC_RELAXED, __HIP_MEMORY_SCOPE_AGENT
#define XB_TMO      128
#define XB_XCNT(j)  (256  + 64 * (j))
#define XB_XSUB(j)  (1280 + 64 * (j))
#define XB_XGEN(j)  (2304 + 64 * (j))
#define XB_TOP      3328
#define XB_TOPGEN   3392
#define XCD_BAR_WORDS 3456
#define XB_SPIN_CAP (1u << 18)
__device__ __forceinline__ unsigned xb_ld(unsigned* p)              { return __hip_atomic_load(p, __ATOMIC_RELAXED, __HIP_MEMORY_SCOPE_AGENT); }
__device__ __forceinline__ unsigned xb_add(unsigned* p, unsigned v) { return __hip_atomic_fetch_add(p, v, __ATOMIC_RELAXED, __HIP_MEMORY_SCOPE_AGENT); }
__device__ __forceinline__ unsigned xb_xcc_id() { return (unsigned)__builtin_amdgcn_s_getreg((3 << 11) | 20) & 0xFu; }
#define XB_SPIN(cond, bar) do { unsigned _sp = 0; while (cond) { __builtin_amdgcn_s_sleep(1); \
    if ((++_sp & 255u) == 0u) { if (xb_ld(&(bar)[XB_TMO])) break; if (_sp > XB_SPIN_CAP) { atomicAdd(&(bar)[XB_TMO], 1u); break; } } } } while (0)
struct XcdBarrier { unsigned* bar; unsigned x; volatile LAS unsigned* st; };
__device__ __forceinline__ XcdBarrier xcd_barrier_post(unsigned* bar, volatile LAS unsigned* st) {
    XcdBarrier b; b.bar = bar; b.x = xb_xcc_id(); b.st = st;
    if (threadIdx.x == 0) (void)xb_add(&bar[XB_XCNT(b.x)], 1u);
    return b;
}
__device__ __forceinline__ void xcd_barrier_complete(unsigned* bar, unsigned x, unsigned& nloc, unsigned& nx) {
    const unsigned G = gridDim.x * gridDim.y * gridDim.z;
    unsigned sum, cnt, mine, sp = 0u;
    for (;;) {
        sum = 0u; cnt = 0u; mine = 0u;
#pragma unroll
        for (unsigned j = 0; j < 16; ++j) { const unsigned c = xb_ld(&bar[XB_XCNT(j)]); sum += c; cnt += (c > 0u) ? 1u : 0u; mine = (j == x) ? c : mine; }
        if (sum == G) break;
        __builtin_amdgcn_s_sleep(1);
        if ((++sp & 255u) == 0u) { if (xb_ld(&bar[XB_TMO])) break; if (sp > XB_SPIN_CAP) { atomicAdd(&bar[XB_TMO], 1u); break; } }
    }
    nloc = mine > 0u ? mine : 1u; nx = cnt > 0u ? cnt : 1u;
}
__device__ __forceinline__ void xcd_barrier(const XcdBarrier& b) {
    asm volatile("s_waitcnt vmcnt(0)" ::: "memory");
    __syncthreads();
    if (threadIdx.x == 0) {
        unsigned* bar = b.bar;
        __builtin_amdgcn_s_waitcnt(0);
        unsigned nloc = b.st[0], nx = b.st[1];
        if (nloc == 0u) { xcd_barrier_complete(bar, b.x, nloc, nx); b.st[0] = nloc; b.st[1] = nx; }
        const unsigned old = xb_add(&bar[XB_XSUB(b.x)], 1u);
        const unsigned gen = old / nloc;
        if (old + 1u == (gen + 1u) * nloc) {
            __builtin_amdgcn_fence(__ATOMIC_RELEASE, "agent");
            asm volatile("s_waitcnt vmcnt(0)" ::: "memory");
            const unsigned og = xb_add(&bar[XB_TOP], 1u);
            const unsigned tg = og / nx;
            if (og + 1u == (tg + 1u) * nx) xb_add(&bar[XB_TOPGEN], 1u);
            else XB_SPIN(xb_ld(&bar[XB_TOPGEN]) == tg, bar);
            __builtin_amdgcn_fence(__ATOMIC_ACQUIRE, "agent");
            xb_add(&bar[XB_XGEN(b.x)], 1u);
            asm volatile("s_waitcnt vmcnt(0)" ::: "memory");
        } else {
            XB_SPIN(xb_ld(&bar[XB_XGEN(b.x)]) == gen, bar);
            __builtin_amdgcn_fence(__ATOMIC_ACQUIRE, "agent");
            asm volatile("s_waitcnt vmcnt(0)" ::: "memory");
        }
    }
    __syncthreads();
}

struct Args { const float* in[22]; float* out; unsigned char* ws; int ph_lo, ph_hi; };
struct Frame {
    LAS unsigned char* lds; int tid, lane, wave, vcu, G;
};
__device__ __forceinline__ float wave_sum(float v) {
#pragma unroll
    for (int o = 1; o < 64; o <<= 1) v += __shfl_xor(v, o);
    return v;
}

constexpr int T0_PITCH = 264;
struct T0Tile { const float* W; int K, N; const float* gk; bf16_t* D; int drow0, k0, n0; };
__device__ __forceinline__ void t0_load(Frame& F, const T0Tile& t, float (&v)[16][2]) {
    const float* src = t.W + (size_t)(t.k0 + F.wave * 16) * t.N + t.n0 + F.lane;
#pragma unroll
    for (int i = 0; i < 16; ++i) { v[i][0] = src[(size_t)i * t.N]; v[i][1] = src[(size_t)i * t.N + 64]; }
}
__device__ __forceinline__ void t0_store(Frame& F, const T0Tile& t, const float (&v)[16][2]) {
#pragma unroll
    for (int i = 0; i < 8; ++i) {
        const int kk = F.wave * 16 + 2 * i;
        const float g0 = t.gk ? t.gk[t.k0 + kk] : 1.f, g1 = t.gk ? t.gk[t.k0 + kk + 1] : 1.f;
#pragma unroll
        for (int j = 0; j < 2; ++j) *(LAS unsigned*)(F.lds + (F.lane + 64 * j) * T0_PITCH + kk * 2) = pk2(v[2 * i][j] * g0, v[2 * i + 1][j] * g1);
    }
    __syncthreads();
    const int n = F.tid >> 2, c = F.tid & 3;
#pragma unroll
    for (int i = 0; i < 4; ++i) {
        const int off = i * 64 + c * 16;
        const u32x2 lo = *(const LAS u32x2*)(F.lds + n * T0_PITCH + off), hi = *(const LAS u32x2*)(F.lds + n * T0_PITCH + off + 8);
        u32x4 w; w.x = lo.x; w.y = lo.y; w.z = hi.x; w.w = hi.y;
        const int gn = t.drow0 + n, rw = gn & 127, w5 = rw & 31, R = (rw & ~31) + 16 * ((w5 >> 2) & 1) + 4 * (w5 >> 3) + (w5 & 3), kk = t.k0 + (off >> 1);
        const size_t tile = ((size_t)(gn >> 8) * (t.K >> 6) + (kk >> 6)) * 2 + ((gn >> 7) & 1);
        *(u32x4*)((char*)t.D + tile * 16384 + pg8::lds_byte(R, kk & 63)) = w;
    }
    __syncthreads();
}

__device__ __forceinline__ void t1_unit(Frame& F, const Args& args, int un, bf16_t* A0) {
    const float* xp = args.in[0]; const float* xs = args.in[1]; const float* cache = args.in[2]; const float* g0p = args.in[5];
    const bool samp = un >= SEQ / 16; const int b = un - SEQ / 16, t0 = samp ? 0 : un * 16;
    LAS float* rs = (LAS float*)(F.lds);
    for (int e = F.wave; e < 31; e += NWAVES) {
        const int t = t0 - 15 + e; float r = 0.f;
        if (t >= 0) { const float* xr = samp ? xs + ((size_t)b * LS + t) * DM : xp + (size_t)t * DM; float s = 0.f;
#pragma unroll 4
            for (int j = 0; j < 16; ++j) { const f32x4 q = *(const f32x4*)(xr + j * 256 + F.lane * 4); s += (q[0] * q[0] + q[1] * q[1]) + (q[2] * q[2] + q[3] * q[3]); }
            r = 1.0f / sqrtf(wave_sum(s) * (1.0f / DM) + EPS); }
        if (F.lane == 0) rs[e] = r;
    }
    __syncthreads();
    const int ch0 = F.tid * 8, w = 2 << (F.tid >> 7);
    const f32x4 ga = *(const f32x4*)(g0p + ch0), gb = *(const f32x4*)(g0p + ch0 + 4);
#define T1_FETCH(e, o0, o1) do { const int _t = t0 - 15 + (e); \
        if (_t >= 0) { const float* _xr = (samp ? xs + ((size_t)b * LS + _t) * DM : xp + (size_t)_t * DM) + ch0; const float _r = rs[(e)]; \
            o0 = *(const f32x4*)_xr * _r * ga; o1 = *(const f32x4*)(_xr + 4) * _r * gb; } \
        else if (samp) { const float* _hr = cache + ((size_t)b * 15 + (e)) * DM + ch0; o0 = *(const f32x4*)_hr; o1 = *(const f32x4*)(_hr + 4); } \
        else { o0 = (f32x4){0.f, 0.f, 0.f, 0.f}; o1 = o0; } } while (0)
    f32x4 s0 = (f32x4){0.f, 0.f, 0.f, 0.f}, s1 = s0;
    for (int e = 16 - w; e < 15; ++e) { f32x4 q0, q1; T1_FETCH(e, q0, q1); s0 += q0; s1 += q1; }
    for (int r = 0; r < 16; ++r) {
        const int e = 15 + r, t = t0 + r; f32x4 c0, c1; T1_FETCH(e, c0, c1); s0 += c0; s1 += c1;
        const float inv = 1.0f / (float)(samp ? w : (t + 1 < w ? t + 1 : w));
        const f32x4 p0 = s0 * inv - c0, p1 = s1 * inv - c1;
        const size_t gr = samp ? (size_t)SEQ + b * LS + t : (size_t)t;
        u32x4 o; o.x = pk2(p0[0], p0[1]); o.y = pk2(p0[2], p0[3]); o.z = pk2(p1[0], p1[1]); o.w = pk2(p1[2], p1[3]);
        *(u32x4*)(A0 + gr * DM + ch0) = o;
        if (samp) { if (r >= 1) { float* po = args.out + O_PRS + ((size_t)b * 15 + (r - 1)) * DM + ch0; *(f32x4*)po = c0; *(f32x4*)(po + 4) = c1; } }
        else if (t >= SEQ - 15) { float* po = args.out + O_PRP + (size_t)(t - (SEQ - 15)) * DM + ch0; *(f32x4*)po = c0; *(f32x4*)(po + 4) = c1; }
        f32x4 q0, q1; T1_FETCH(e - w + 1, q0, q1); s0 -= q0; s1 -= q1;
    }
#undef T1_FETCH
    __syncthreads();
}

constexpr int L_AP = 0, L_APT = 8704, L_BB = 17408, L_CC = 25600, L_CCT = 33792, L_KT = 41984, L_DD = 50176, L_XW = 50432, L_RS = 54528, L_TAB = 87808;
constexpr int FT_PITCH = 528, ET_PITCH = 272;
static_assert(L_TAB + 256 * ET_PITCH <= LDSCTL_OFF && L_TAB + 128 * FT_PITCH <= LDSCTL_OFF, "SSM LDS map");
__device__ __forceinline__ f32x2 cmul(f32x2 a, f32x2 b) { return (f32x2){a.x * b.x - a.y * b.y, a.x * b.y + a.y * b.x}; }
__device__ __forceinline__ float gelu_tanh(float x) {
    const float z = 0.7978845608028654f * (x + 0.044715f * x * x * x);
    const float e = __expf(2.0f * z);
    const float th = 1.0f - 2.0f * __builtin_amdgcn_rcpf(1.0f + e);
    return 0.5f * x * (1.0f + th);
}
__device__ __forceinline__ void ssm_load_u(const bf16_t* Ug, int mt, int fr, int q, u32x4 (&raw)[8]) {
    const int chunk = mt * 16 + fr; const bool valid = chunk < NCHUNK;
#pragma unroll
    for (int ks = 0; ks < 8; ++ks) raw[ks] = valid ? *(const u32x4*)(Ug + ((size_t)chunk * 16 + 2 * ks + (q >> 1)) * 16 + (q & 1) * 8) : (u32x4){0u, 0u, 0u, 0u};
}
__device__ __forceinline__ void ssm_load_h(const unsigned* Hg, int mt, int fr, int q, u32x4 (&hw)[4]) {
    const int chunk = mt * 16 + fr; const bool valid = chunk < NCHUNK;
#pragma unroll
    for (int kh = 0; kh < 4; ++kh) hw[kh] = valid ? *(const u32x4*)(Hg + (size_t)chunk * 64 + kh * 16 + q * 4) : (u32x4){0u, 0u, 0u, 0u};
}
__device__ __forceinline__ bf16x8 ssm_scale(const u32x4 raw, float r, const float (&g8)[8]) {
    u32x4 w; w.x = cvt_pk_bf16_c(bf_lo(raw.x) * (r * g8[0]), bf_hi(raw.x) * (r * g8[1])); w.y = cvt_pk_bf16_c(bf_lo(raw.y) * (r * g8[2]), bf_hi(raw.y) * (r * g8[3]));
    w.z = cvt_pk_bf16_c(bf_lo(raw.z) * (r * g8[4]), bf_hi(raw.z) * (r * g8[5])); w.w = cvt_pk_bf16_c(bf_lo(raw.w) * (r * g8[6]), bf_hi(raw.w) * (r * g8[7]));
    return __builtin_bit_cast(bf16x8, w);
}
__device__ __forceinline__ void ssm_s_tile(const u32x4 (&raw)[8], const float (&g8)[8], int mt, int fr, int q, const LAS float* RS, const LAS unsigned char* TAB, unsigned* Sg) {
    const int chunk = mt * 16 + fr; const bool valid = chunk < NCHUNK;
    f32x4 acc[8];
#pragma unroll
    for (int i = 0; i < 8; ++i) acc[i] = (f32x4){0.f, 0.f, 0.f, 0.f};
#pragma unroll
    for (int ks = 0; ks < 8; ++ks) {
        const bf16x8 af = ssm_scale(raw[ks], valid ? RS[chunk * 16 + 2 * ks + (q >> 1)] : 0.f, g8);
#pragma unroll
        for (int nt = 0; nt < 8; ++nt) { const bf16x8 bfr = *(const LAS bf16x8*)(TAB + (nt * 16 + fr) * FT_PITCH + (ks * 32 + q * 8) * 2);
            acc[nt] = __builtin_amdgcn_mfma_f32_16x16x32_bf16(bfr, af, acc[nt], 0, 0, 0); }
    }
    asm volatile("s_nop 7\n\ts_nop 7" : "+v"(acc[0]), "+v"(acc[1]), "+v"(acc[2]), "+v"(acc[3]), "+v"(acc[4]), "+v"(acc[5]), "+v"(acc[6]), "+v"(acc[7]));
#pragma unroll
    for (int nt = 0; nt < 4; ++nt) { u32x4 w;
        w.x = cvt_pk_bf16(acc[nt][0], acc[nt + 4][0]); w.y = cvt_pk_bf16(acc[nt][1], acc[nt + 4][1]); w.z = cvt_pk_bf16(acc[nt][2], acc[nt + 4][2]); w.w = cvt_pk_bf16(acc[nt][3], acc[nt + 4][3]);
        *(u32x4*)(Sg + (size_t)chunk * 64 + nt * 16 + q * 4) = w; }
}
__device__ __forceinline__ void ssm_y_tile(const u32x4 (&raw)[8], const float (&g8)[8], const unsigned* Hg, int mt, int fr, int q, const LAS float* RS, const LAS bf16_t* KT, const LAS unsigned char* ET, bf16_t* Yg) {
    const int chunk = mt * 16 + fr; const bool valid = chunk < NCHUNK;
    u32x4 hw[4]; ssm_load_h(Hg, mt, fr, q, hw);
    f32x4 acc[16];
#pragma unroll
    for (int i = 0; i < 16; ++i) acc[i] = (f32x4){0.f, 0.f, 0.f, 0.f};
#pragma unroll
    for (int ks = 0; ks < 8; ++ks) {
        const int s = 2 * ks + (q >> 1), c0 = (q & 1) * 8;
        const bf16x8 af = ssm_scale(raw[ks], valid ? RS[chunk * 16 + s] : 0.f, g8);
#pragma unroll
        for (int j = 2 * ks; j < 16; ++j) {
            const int d = j - s;
            u32x4 bw = *(const LAS u32x4*)(KT + ((d < 0 ? 0 : d) * 256 + fr * 16 + c0));
            if (d < 0) bw = (u32x4){0u, 0u, 0u, 0u};
            acc[j] = __builtin_amdgcn_mfma_f32_16x16x32_bf16(__builtin_bit_cast(bf16x8, bw), af, acc[j], 0, 0, 0);
            if ((j & 3) == 3) __builtin_amdgcn_sched_barrier(0);
        }
    }
#pragma unroll
    for (int kh = 0; kh < 4; ++kh) {
        const bf16x8 af = __builtin_bit_cast(bf16x8, hw[kh]);
#pragma unroll
        for (int j = 0; j < 16; ++j) { const bf16x8 bfr = *(const LAS bf16x8*)(ET + (j * 16 + fr) * ET_PITCH + (kh * 32 + q * 8) * 2);
            acc[j] = __builtin_amdgcn_mfma_f32_16x16x32_bf16(bfr, af, acc[j], 0, 0, 0);
            if ((j & 3) == 3) __builtin_amdgcn_sched_barrier(0); }
    }
    if (valid) {
#pragma unroll
        for (int j = 0; j < 16; ++j) { u32x2 o; o.x = cvt_pk_bf16(gelu_tanh(acc[j][0]), gelu_tanh(acc[j][1])); o.y = cvt_pk_bf16(gelu_tanh(acc[j][2]), gelu_tanh(acc[j][3]));
            *(u32x2*)(Yg + ((size_t)chunk * 16 + j) * 16 + q * 4) = o; }
    }
}
__device__ __forceinline__ void ssm_group(Frame& F, const Args& args, int g, const bf16_t* UgAll, bf16_t* YgAll, const float* ss, unsigned* SgAll, unsigned* HgAll) {
    LAS f32x2* AP = (LAS f32x2*)(F.lds + L_AP);
    LAS f32x2* APT = (LAS f32x2*)(F.lds + L_APT);
    LAS f32x2* BB = (LAS f32x2*)(F.lds + L_BB);
    LAS f32x2* CC = (LAS f32x2*)(F.lds + L_CC);
    LAS f32x2* CCT = (LAS f32x2*)(F.lds + L_CCT);
    LAS bf16_t* KT = (LAS bf16_t*)(F.lds + L_KT);
    LAS float* DD = (LAS float*)(F.lds + L_DD);
    LAS f32x2* XW = (LAS f32x2*)(F.lds + L_XW);
    LAS float* RS = (LAS float*)(F.lds + L_RS);
    LAS unsigned char* TAB = F.lds + L_TAB;
    const bf16_t* Ug = UgAll + (size_t)g * MROWS * 16; bf16_t* Yg = YgAll + (size_t)g * MROWS * 16;
    unsigned* Sg = SgAll + (size_t)g * NCHP * 64; unsigned* Hg = HgAll + (size_t)g * NCHP * 64;
    const int tid = F.tid, lane = F.lane, wave = F.wave, fr = lane & 15, q = lane >> 4;
    float g8[8];
#pragma unroll
    for (int i = 0; i < 8; ++i) g8[i] = args.in[5][DM + g * CG + (q & 1) * 8 + i];
    {
        const float dt = expf(args.in[10][g]);
        for (int e = tid; e < 17 * PST; e += NWAVES * 64) { const int tau = e >> 6, p = e & 63;
            const float are = args.in[8][g * PST + p], aim = args.in[9][g * PST + p];
            double ang = (double)aim * (double)dt * (double)tau; ang -= 6.283185307179586 * floor(ang * 0.15915494309189535);
            float sn, cs; sincosf((float)ang, &sn, &cs); const float mag = expf(are * dt * (float)tau);
            const f32x2 v = (f32x2){mag * cs, mag * sn}; AP[e] = v; APT[p * 17 + tau] = v; }
        if (tid < PST) { const int p = tid;
            const float are = args.in[8][g * PST + p], aim = args.in[9][g * PST + p]; const f32x2 z = (f32x2){are * dt, aim * dt}; f32x2 qv;
            if (z.x * z.x + z.y * z.y < 0.0625f) { f32x2 h = (f32x2){1.f, 0.f};
#pragma unroll
                for (int k = 8; k >= 2; --k) { h = cmul(z, h); h.x = 1.f + h.x * (1.0f / k); h.y = h.y * (1.0f / k); }
                qv = (f32x2){dt * h.x, dt * h.y};
            } else { float sn, cs; sincosf(z.y, &sn, &cs); const float mag = expf(z.x); const float nr = mag * cs - 1.0f, ni = mag * sn, den = 1.0f / (are * are + aim * aim);
                qv = (f32x2){(nr * are + ni * aim) * den, (ni * are - nr * aim) * den}; }
            XW[p] = qv; }
        for (int e = tid; e < CG * PST; e += NWAVES * 64) { const f32x2 v = (f32x2){args.in[13][(size_t)g * CG * PST + e], args.in[14][(size_t)g * CG * PST + e]}; CC[e] = v; CCT[(e & 63) * 16 + (e >> 6)] = v; }
        if (tid < CG) DD[tid] = args.in[15][g * CG + tid];
        for (int e = tid; e < MROWS; e += NWAVES * 64) RS[e] = __builtin_amdgcn_rsqf(ss[e] * (1.0f / DM) + EPS);
        __syncthreads();
        for (int e = tid; e < PST * CG; e += NWAVES * 64) { const int p = e >> 4;
            BB[e] = cmul(XW[p], (f32x2){args.in[11][(size_t)g * PST * CG + e], args.in[12][(size_t)g * PST * CG + e]}); }
    }
    __syncthreads();
    {
        const int tau = tid >> 5, c = (tid >> 1) & 15, c0 = (tid & 1) * 8; float k8[8];
#pragma unroll
        for (int i = 0; i < 8; ++i) k8[i] = (tau == 0 && c == c0 + i) ? DD[c] : 0.f;
        for (int p = 0; p < PST; ++p) { const f32x2 m = cmul(CCT[p * 16 + c], AP[tau * 64 + p]);
#pragma unroll
            for (int i = 0; i < 8; ++i) { const f32x2 bb = BB[p * 16 + c0 + i]; k8[i] += m.x * bb.x - m.y * bb.y; } }
        u32x4 w; w.x = pk2(k8[0], k8[1]); w.y = pk2(k8[2], k8[3]); w.z = pk2(k8[4], k8[5]); w.w = pk2(k8[6], k8[7]);
        *(LAS u32x4*)(KT + (tau * 256 + c * 16 + c0)) = w;
        for (int e = tid; e < 128 * 128; e += NWAVES * 64) {
            const int n = e >> 7, k = (e & 127) * 2, p = n & 63, s = k >> 4, cp = k & 15;
            const f32x2 ap = APT[p * 17 + 15 - s], v0 = cmul(ap, BB[p * 16 + cp]), v1 = cmul(ap, BB[p * 16 + cp + 1]);
            *(LAS unsigned*)(TAB + n * FT_PITCH + k * 2) = (n >> 6) ? pk2(v0.y, v1.y) : pk2(v0.x, v1.x);
        }
    }
    __syncthreads();
    { u32x4 ra[8], rb[8]; int mt = wave;
      if (mt < NCHP / 16) ssm_load_u(Ug, mt, fr, q, ra);
      while (mt < NCHP / 16) {
          const int m2 = mt + NWAVES; if (m2 < NCHP / 16) ssm_load_u(Ug, m2, fr, q, rb);
          ssm_s_tile(ra, g8, mt, fr, q, RS, TAB, Sg);
          mt = m2; if (mt >= NCHP / 16) break;
          const int m3 = mt + NWAVES; if (m3 < NCHP / 16) ssm_load_u(Ug, m3, fr, q, ra);
          ssm_s_tile(rb, g8, mt, fr, q, RS, TAB, Sg);
          mt = m3; } }
    asm volatile("s_waitcnt vmcnt(0)" ::: "memory");
    __syncthreads();
    {
        const f32x2 a16 = AP[16 * 64 + lane];
        const unsigned* Sl = Sg + (size_t)(wave * 64) * 64 + lane;
        unsigned sv[64];
#pragma unroll
        for (int i = 0; i < 64; ++i) sv[i] = __hip_atomic_load(Sl + (size_t)i * 64, RLX_AGENT);
        for (int e = tid; e < 256 * 64; e += NWAVES * 64) {
            const int n = e >> 6, p = e & 63, j = n >> 4, c = n & 15;
            const f32x2 z = cmul(CC[c * 64 + p], AP[(j + 1) * 64 + p]);
            *(LAS unsigned*)(TAB + n * ET_PITCH + p * 4) = pk2(z.x, -z.y);
        }
        f32x2 T = (f32x2){0.f, 0.f};
#pragma unroll
        for (int i = 0; i < 64; ++i) { T = cmul(a16, T); T.x += bf_lo(sv[i]); T.y += bf_hi(sv[i]); }
        XW[wave * 64 + lane] = T;
        __syncthreads();
        f32x2 a64 = a16;
#pragma unroll
        for (int i = 0; i < 6; ++i) a64 = cmul(a64, a64);
        f32x2 Hc = (f32x2){0.f, 0.f};
        for (int v = 0; v < wave; ++v) { Hc = cmul(a64, Hc); const f32x2 tv = XW[v * 64 + lane]; Hc.x += tv.x; Hc.y += tv.y; }
        unsigned* Hl = Hg + (size_t)(wave * 64) * 64 + lane;
#pragma unroll
        for (int i = 0; i < 64; ++i) { Hl[(size_t)i * 64] = cvt_pk_bf16(Hc.x, Hc.y); Hc = cmul(a16, Hc); Hc.x += bf_lo(sv[i]); Hc.y += bf_hi(sv[i]); }
        if (wave == NWAVES - 1) { args.out[O_SRP + (size_t)g * PST + lane] = Hc.x; args.out[O_SIP + (size_t)g * PST + lane] = Hc.y; }
        if (wave == 0) {
            f32x2 h0s[NB]; unsigned s0s[NB];
#pragma unroll
            for (int b = 0; b < NB; ++b) { const int c = SEQ / 16 + b;
                h0s[b] = (f32x2){args.in[3][((size_t)b * NGRP + g) * PST + lane], args.in[4][((size_t)b * NGRP + g) * PST + lane]};
                s0s[b] = __hip_atomic_load(Sg + (size_t)c * 64 + lane, RLX_AGENT); }
#pragma unroll
            for (int b = 0; b < NB; ++b) { const int c = SEQ / 16 + b;
                Hg[(size_t)c * 64 + lane] = cvt_pk_bf16(h0s[b].x, h0s[b].y);
                f32x2 ho = cmul(a16, h0s[b]); ho.x += bf_lo(s0s[b]); ho.y += bf_hi(s0s[b]);
                args.out[O_SRS + ((size_t)b * NGRP + g) * PST + lane] = ho.x; args.out[O_SIS + ((size_t)b * NGRP + g) * PST + lane] = ho.y; }
        }
    }
    asm volatile("s_waitcnt vmcnt(0)" ::: "memory");
    __syncthreads();
    { u32x4 ra[8], rb[8]; int mt = wave;
      if (mt < NCHP / 16) ssm_load_u(Ug, mt, fr, q, ra);
      while (mt < NCHP / 16) {
          const int m2 = mt + NWAVES; if (m2 < NCHP / 16) ssm_load_u(Ug, m2, fr, q, rb);
          ssm_y_tile(ra, g8, Hg, mt, fr, q, RS, KT, TAB, Yg);
          mt = m2; if (mt >= NCHP / 16) break;
          const int m3 = mt + NWAVES; if (m3 < NCHP / 16) ssm_load_u(Ug, m3, fr, q, ra);
          ssm_y_tile(rb, g8, Hg, mt, fr, q, RS, KT, TAB, Yg);
          mt = m3; } }
    __syncthreads();
}

template <int MODE>
__device__ __forceinline__ void fixup_rows(Frame& F, const Args& args, unsigned char* ws, const float* ss_in, float* ss_out, const bf16_t* Rin, bf16_t* Aout) {
    const bf16_t* slab = (const bf16_t*)(ws + WS_SLAB);
    LAS float* red = (LAS float*)F.lds;
    constexpr int NSPL = (MODE == 1 || MODE == 2) ? 4 : (MODE == 5 ? 8 : 16), LD = (MODE == 2) ? DFF : (MODE == 5 ? 2 * DM : DM);
    for (int r = F.vcu; r < NSAMP; r += F.G) {
        const int gr = SEQ + r, c0 = F.tid * 8;
        if constexpr (MODE == 2) {
            const float rstd = __builtin_amdgcn_rsqf(ss_in[gr] * (1.0f / DM) + EPS);
            bf16_t* HB = (bf16_t*)(ws + WS_H);
#pragma unroll 1
            for (int seg = 0; seg < 4; ++seg) { const int col = seg * DM + c0;
                f32x4 v0 = (f32x4){0.f, 0.f, 0.f, 0.f}, v1 = v0;
#pragma unroll
                for (int sp = 0; sp < NSPL; ++sp) { const u32x4 pw = *(const u32x4*)(slab + ((size_t)sp * NSAMP + r) * LD + col);
                    v0 += (f32x4){bf_lo(pw.x), bf_hi(pw.x), bf_lo(pw.y), bf_hi(pw.y)}; v1 += (f32x4){bf_lo(pw.z), bf_hi(pw.z), bf_lo(pw.w), bf_hi(pw.w)}; }
#pragma unroll
                for (int j = 0; j < 4; ++j) { const float p0 = fmaxf(v0[j] * rstd, 0.f), p1 = fmaxf(v1[j] * rstd, 0.f); v0[j] = p0 * p0; v1[j] = p1 * p1; }
                u32x4 w; w.x = cvt_pk_bf16(v0[0], v0[1]); w.y = cvt_pk_bf16(v0[2], v0[3]); w.z = cvt_pk_bf16(v1[0], v1[1]); w.w = cvt_pk_bf16(v1[2], v1[3]);
                *(u32x4*)((char*)HB + tiled_off(gr, col, DFF / 64)) = w; }
        } else {
            const int scol = (MODE == 5) ? ((c0 >> 7) * 256 + (c0 & 127)) : c0;
            f32x4 v0 = (f32x4){0.f, 0.f, 0.f, 0.f}, v1 = v0, b0 = v0, b1 = v0;
#pragma unroll
            for (int sp = 0; sp < NSPL; ++sp) { const bf16_t* p = slab + ((size_t)sp * NSAMP + r) * LD + scol; const u32x4 pw = *(const u32x4*)p;
                v0 += (f32x4){bf_lo(pw.x), bf_hi(pw.x), bf_lo(pw.y), bf_hi(pw.y)}; v1 += (f32x4){bf_lo(pw.z), bf_hi(pw.z), bf_lo(pw.w), bf_hi(pw.w)};
                if constexpr (MODE == 5) { const u32x4 qw = *(const u32x4*)(p + 128);
                    b0 += (f32x4){bf_lo(qw.x), bf_hi(qw.x), bf_lo(qw.y), bf_hi(qw.y)}; b1 += (f32x4){bf_lo(qw.z), bf_hi(qw.z), bf_lo(qw.w), bf_hi(qw.w)}; } }
            if constexpr (MODE == 1) { const float* xr = args.in[1] + (size_t)r * DM + c0; const float* sc = args.in[7] + c0;
                v0 = *(const f32x4*)xr + *(const f32x4*)sc * v0; v1 = *(const f32x4*)(xr + 4) + *(const f32x4*)(sc + 4) * v1; }
            else { const u32x4 rw = (MODE == 5) ? *(const u32x4*)(Rin + ((size_t)(c0 >> 4) * MROWS + gr) * 16 + (c0 & 15)) : *(const u32x4*)((const char*)Rin + tiled_off(gr, c0, DM / 64));
                if constexpr (MODE == 5) {
#pragma unroll
                    for (int j = 0; j < 4; ++j) { v0[j] *= sigmoidf_(b0[j]); v1[j] *= sigmoidf_(b1[j]); } }
                v0 += (f32x4){bf_lo(rw.x), bf_hi(rw.x), bf_lo(rw.y), bf_hi(rw.y)}; v1 += (f32x4){bf_lo(rw.z), bf_hi(rw.z), bf_lo(rw.w), bf_hi(rw.w)}; }
            float ss = (v0[0] * v0[0] + v0[1] * v0[1]) + (v0[2] * v0[2] + v0[3] * v0[3]) + (v1[0] * v1[0] + v1[1] * v1[1]) + (v1[2] * v1[2] + v1[3] * v1[3]);
            ss = wave_sum(ss); if (F.lane == 0) red[F.wave] = ss;
            __syncthreads();
            ss = ((red[0] + red[1]) + (red[2] + red[3])) + ((red[4] + red[5]) + (red[6] + red[7]));
            __syncthreads();
            if constexpr (MODE == 7) {
                const float rstd = 1.0f / sqrtf(ss * (1.0f / DM) + EPS); const float* gf = args.in[21] + c0; float* yo = args.out + O_YP + (size_t)gr * DM + c0;
                *(f32x4*)yo = v0 * rstd * *(const f32x4*)gf; *(f32x4*)(yo + 4) = v1 * rstd * *(const f32x4*)(gf + 4);
            } else {
                if (F.tid == 0) ss_out[gr] = ss;
                u32x4 w; w.x = cvt_pk_bf16(v0[0], v0[1]); w.y = cvt_pk_bf16(v0[2], v0[3]); w.z = cvt_pk_bf16(v1[0], v1[1]); w.w = cvt_pk_bf16(v1[2], v1[3]);
                if constexpr (MODE == 3) *(u32x4*)(Aout + ((size_t)(c0 >> 4) * MROWS + gr) * 16 + (c0 & 15)) = w;
                else *(u32x4*)((char*)Aout + tiled_off(gr, c0, DM / 64)) = w;
            }
        }
    }
}

__global__ void __launch_bounds__(NWAVES * 64, 2) trunk_fwd(Args args) {
    extern __shared__ __attribute__((aligned(16))) unsigned char lds[];
    Frame F;
    F.lds = (LAS unsigned char*)lds;
    F.tid = threadIdx.x; F.lane = F.tid & 63; F.wave = __builtin_amdgcn_readfirstlane(F.tid >> 6);
    F.G = gridDim.x; { const int bx = blockIdx.x; F.vcu = (F.G % 8 == 0) ? (bx % 8) * (F.G / 8) + bx / 8 : bx; }
    volatile LAS unsigned* MISC = (volatile LAS unsigned*)(F.lds + MISC_OFF);
    unsigned char* ws = args.ws;
    unsigned* ctl = (unsigned*)(ws + WS_CTL);
    for (int u = F.tid; u < 512 / 4; u += NWAVES * 64) ((LAS unsigned*)(F.lds + LDSCTL_OFF))[u] = 0u;
    __syncthreads();
    XcdBarrier bar; bar.bar = ctl + CW_BAR; bar.x = 0; bar.st = nullptr;
    if (N_LAUNCHES == 1) bar = xcd_barrier_post(ctl + CW_BAR, MISC + 8);
#define GRID_BAR() do { if (N_LAUNCHES == 1) xcd_barrier(bar); } while (0)
    const int lo = args.ph_lo, hi = args.ph_hi;
#define IN(k) (lo <= (k) && (k) < hi)
    bf16_t* WPOOL = (bf16_t*)(ws + WS_WPOOL); bf16_t* WGLU = (bf16_t*)(ws + WS_WGLU);
    bf16_t* WUP0 = (bf16_t*)(ws + WS_WUP0); bf16_t* WUP1 = (bf16_t*)(ws + WS_WUP1); bf16_t* WDN0 = (bf16_t*)(ws + WS_WDN0); bf16_t* WDN1 = (bf16_t*)(ws + WS_WDN1);
    bf16_t* A2 = (bf16_t*)(ws + WS_X); bf16_t* A0 = (bf16_t*)(ws + WS_A0); bf16_t* A1 = (bf16_t*)(ws + WS_A1); bf16_t* HB = (bf16_t*)(ws + WS_H);
    bf16_t* SLAB = (bf16_t*)(ws + WS_SLAB); float* SS1 = (float*)(ws + WS_SS); float* SS2 = SS1 + MROWS; float* SS3 = SS2 + MROWS; float* SS4 = SS3 + MROWS;

    if (IN(0)) {
        constexpr int T_POOL = 4 * 8 * 8, T_UP = 32 * 128, T_DN = 128 * 32, T_GLU = 32 * 32;
        constexpr int NT_ALL = T_POOL + 2 * T_UP + 2 * T_DN + 2 * T_GLU;
#define T0_DESC(it_, T) do { int r = (it_); \
            if (r < T_POOL) { const int gi = r >> 6, kb = (r >> 3) & 7, nb = r & 7; T = T0Tile{args.in[6] + (size_t)gi * 1024 * 1024, 1024, 1024, nullptr, WPOOL, gi * 1024 + nb * 128, kb * 128, nb * 128}; break; } r -= T_POOL; \
            if (r < 2 * T_UP) { const int l = r / T_UP, rr = r % T_UP, kb = rr >> 7, nb = rr & 127; T = T0Tile{args.in[19] + (size_t)l * DM * DFF, DM, DFF, args.in[18] + l * DM, l ? WUP1 : WUP0, nb * 128, kb * 128, nb * 128}; break; } r -= 2 * T_UP; \
            if (r < 2 * T_DN) { const int l = r / T_DN, rr = r % T_DN, kb = rr >> 5, nb = rr & 31; T = T0Tile{args.in[20] + (size_t)l * DFF * DM, DFF, DM, nullptr, l ? WDN1 : WDN0, nb * 128, kb * 128, nb * 128}; break; } r -= 2 * T_DN; \
            { const int ab = r / T_GLU, rr = r % T_GLU, kb = rr >> 5, nb = rr & 31; T = T0Tile{args.in[ab ? 17 : 16], DM, DM, nullptr, WGLU, nb * 256 + ab * 128, kb * 128, nb * 128}; } } while (0)
        {
            float va[16][2], vb[16][2]; T0Tile ta, tb; int it = F.vcu;
            if (it < NT_ALL) { T0_DESC(it, ta); t0_load(F, ta, va); }
            while (it < NT_ALL) {
                const int i1 = it + F.G, i2 = it + 2 * F.G;
                if (i1 < NT_ALL) { T0_DESC(i1, tb); t0_load(F, tb, vb); }
                t0_store(F, ta, va);
                if (i2 < NT_ALL) { T0_DESC(i2, ta); t0_load(F, ta, va); }
                if (i1 < NT_ALL) t0_store(F, tb, vb);
                it = i2;
            }
        }
#undef T0_DESC
        for (int un = F.vcu; un < NCHUNK; un += F.G) t1_unit(F, args, un, A0);
#if REP_POOL > 1
        for (int un = F.vcu; un < NCHUNK; un += F.G) t1_unit(F, args, un, A0);
#endif
        if (IN(1)) GRID_BAR();
    }
    if (IN(1)) {
        pg8::Gemm g{(const char*)A0, (const char*)WPOOL, DM * 2u, 32u, 1024 * 2u, 16, 4, 64, 0u};
        pg8::Sched S; S.init(16, F.G, (int)blockIdx.x, 4);
        Epi<1> E{{args.in[0], args.in[1], nullptr, A1, nullptr, nullptr, args.in[7], nullptr, SS1, SLAB, DM}};
        pg8::gemm_phase(F.lds, g, S, E);
        if (IN(2)) GRID_BAR();
    }
    if (IN(2)) { fixup_rows<1>(F, args, ws, nullptr, SS1, nullptr, A1); if (IN(3)) GRID_BAR(); }
    if (IN(3)) {
        pg8::Gemm g{(const char*)A1, (const char*)WUP0, 0u, 8192u, DM * 2u, 64, 16, 0, (DM / 64) * 32768u};
        pg8::Sched S; S.init(64, F.G, (int)blockIdx.x, 4);
        Epi<2> E{{nullptr, nullptr, nullptr, nullptr, HB, nullptr, nullptr, SS1, nullptr, SLAB, DFF}};
        pg8::gemm_phase(F.lds, g, S, E);
#if REP_UP > 1
        __syncthreads();
        pg8::gemm_phase(F.lds, g, S, E);
#endif
        if (IN(4)) GRID_BAR();
    }
    if (IN(4)) { fixup_rows<2>(F, args, ws, SS1, nullptr, nullptr, nullptr); if (IN(5)) GRID_BAR(); }
    if (IN(5)) {
        pg8::Gemm g{(const char*)HB, (const char*)WDN0, 0u, 8192u, DFF * 2u, 256, 16, 0, (DFF / 64) * 32768u};
        pg8::Sched S; S.init(16, F.G, (int)blockIdx.x, 16);
        Epi<3> E{{nullptr, nullptr, A1, A0, nullptr, nullptr, nullptr, nullptr, SS2, SLAB, DM}};
        pg8::gemm_phase(F.lds, g, S, E);
        if (IN(6)) GRID_BAR();
    }
    if (IN(6)) { fixup_rows<3>(F, args, ws, nullptr, SS2, A1, A0); if (IN(7)) GRID_BAR(); }
    if (IN(7)) {
        for (int g = F.vcu; g < NGRP; g += F.G) ssm_group(F, args, g, A0, A1, SS2, (unsigned*)(ws + WS_SG), (unsigned*)(ws + WS_HG));
#if REP_SSM > 1
        for (int g = F.vcu; g < NGRP; g += F.G) ssm_group(F, args, g, A0, A1, SS2, (unsigned*)(ws + WS_SG), (unsigned*)(ws + WS_HG));
#endif
        if (IN(8)) GRID_BAR();
    }
    if (IN(8)) {
        pg8::Gemm g{(const char*)A1, (const char*)WGLU, 32u, (unsigned)MROWS * 32u, DM * 2u, 64, 8, 0, 0u};
        pg8::Sched S; S.init(32, F.G, (int)blockIdx.x, 8);
        Epi<4> E{{nullptr, nullptr, A0, A2, nullptr, nullptr, nullptr, nullptr, SS3, SLAB, 2 * DM}};
        pg8::gemm_phase(F.lds, g, S, E);
        if (IN(9)) GRID_BAR();
    }
    if (IN(9)) { fixup_rows<5>(F, args, ws, nullptr, SS3, A0, A2); if (IN(10)) GRID_BAR(); }
    if (IN(10)) {
        pg8::Gemm g{(const char*)A2, (const char*)WUP1, 0u, 8192u, DM * 2u, 64, 16, 0, (DM / 64) * 32768u};
        pg8::Sched S; S.init(64, F.G, (int)blockIdx.x, 4);
        Epi<2> E{{nullptr, nullptr, nullptr, nullptr, HB, nullptr, nullptr, SS3, nullptr, SLAB, DFF}};
        pg8::gemm_phase(F.lds, g, S, E);
        if (IN(11)) GRID_BAR();
    }
    if (IN(11)) { fixup_rows<2>(F, args, ws, SS3, nullptr, nullptr, nullptr); if (IN(12)) GRID_BAR(); }
    if (IN(12)) {
        pg8::Gemm g{(const char*)HB, (const char*)WDN1, 0u, 8192u, DFF * 2u, 256, 16, 0, (DFF / 64) * 32768u};
        pg8::Sched S; S.init(16, F.G, (int)blockIdx.x, 16);
        Epi<5> E{{nullptr, nullptr, A2, A1, nullptr, nullptr, nullptr, nullptr, SS4, SLAB, DM}};
        pg8::gemm_phase(F.lds, g, S, E);
        if (IN(13)) GRID_BAR();
    }
    if (IN(13)) {
        fixup_rows<7>(F, args, ws, nullptr, nullptr, A2, nullptr);
        const float* gf = args.in[21];
        const int gw = F.vcu * NWAVES + F.wave, NGW = F.G * NWAVES;
        for (int m = gw; m < SEQ; m += NGW) {
            float* row = args.out + O_YP + (size_t)m * DM + F.lane * 8; const bf16_t* xr = A1 + (size_t)m * DM + F.lane * 8;
            const float r = 1.0f / sqrtf(SS4[m] * (1.0f / DM) + EPS);
#pragma unroll 4
            for (int j = 0; j < 8; ++j) { const u32x4 w = *(const u32x4*)(xr + j * 512); const f32x4 g0 = *(const f32x4*)(gf + j * 512 + F.lane * 8), g1 = *(const f32x4*)(gf + j * 512 + F.lane * 8 + 4);
                *(f32x4*)(row + j * 512) = (f32x4){bf_lo(w.x), bf_hi(w.x), bf_lo(w.y), bf_hi(w.y)} * r * g0; *(f32x4*)(row + j * 512 + 4) = (f32x4){bf_lo(w.z), bf_hi(w.z), bf_lo(w.w), bf_hi(w.w)} * r * g1; }
        }
    }
#undef IN
#undef GRID_BAR
}

extern "C" void kernel_launch(void* const* d_in, const int* in_sizes, int n_in, void* d_out, int out_size, void* d_ws, size_t ws_size, hipStream_t stream) {
    static int grid = 0;
    if (grid == 0) {
        if (n_in != 22 || in_sizes[0] != SEQ * DM || (size_t)out_size != O_END || ws_size < WS_END) {
            fprintf(stderr, "kernel_launch: unexpected shapes (n_in %d, in0 %d, out %d, ws %zu); nothing launched\n", n_in, n_in > 0 ? in_sizes[0] : -1, out_size, ws_size); grid = -1; return; }
        int dev = 0, cus = 0, per_cu = 0;
        if (hipGetDevice(&dev) != hipSuccess || hipDeviceGetAttribute(&cus, hipDeviceAttributeMultiprocessorCount, dev) != hipSuccess) { fprintf(stderr, "kernel_launch: device query failed\n"); grid = -1; return; }
        if (hipFuncSetAttribute((const void*)trunk_fwd, hipFuncAttributeMaxDynamicSharedMemorySize, LDS_BYTES) != hipSuccess) { fprintf(stderr, "kernel_launch: hipFuncSetAttribute failed\n"); grid = -1; return; }
        if (hipOccupancyMaxActiveBlocksPerMultiprocessor(&per_cu, (const void*)trunk_fwd, NWAVES * 64, LDS_BYTES) != hipSuccess || per_cu < 1)
            fprintf(stderr, "kernel_launch: note: occupancy query reports %d workgroups per CU\n", per_cu);
        (void)hipGetLastError();
        grid = cus;
    }
    if (grid < 0) return;
    if (hipMemsetAsync((char*)d_ws + WS_CTL, 0, CTL_ZERO_BYTES, stream) != hipSuccess) { fprintf(stderr, "kernel_launch: memset failed\n"); return; }
    Args a{};
    for (int i = 0; i < 22; ++i) a.in[i] = (const float*)d_in[i];
    a.out = (float*)d_out; a.ws = (unsigned char*)d_ws;
    for (int li = 0; li < N_LAUNCHES; ++li) {
        a.ph_lo = (N_LAUNCHES == 1) ? 0 : li; a.ph_hi = (N_LAUNCHES == 1) ? NPHASE : li + 1;
        hipLaunchKernelGGL(trunk_fwd, dim3(grid), dim3(NWAVES * 64), LDS_BYTES, stream, a);
        const hipError_t le = hipPeekAtLastError();
        if (le != hipSuccess) { fprintf(stderr, "kernel_launch: launch %d failed: %s\n", li, hipGetErrorName(le)); break; }
    }
}
```

```cpp
#include <hip/hip_runtime.h>
#include <cstdio>
#include <cstdint>

#define LAS __attribute__((address_space(3)))
#define GAS __attribute__((address_space(1)))
typedef unsigned short bf16_t;
typedef short bf16x8 __attribute__((ext_vector_type(8)));
typedef float f32x4 __attribute__((ext_vector_type(4)));
typedef float f32x2 __attribute__((ext_vector_type(2)));
typedef unsigned u32x4 __attribute__((ext_vector_type(4)));
typedef unsigned u32x2 __attribute__((ext_vector_type(2)));

constexpr int DM = 4096, DFF = 16384, SEQ = 8192, NB = 8, LS = 16, NSAMP = NB * LS, MROWS = SEQ + NSAMP;
constexpr int NGRP = 256, PST = 64, CG = 16;
constexpr int NCHUNK = MROWS / 16;
constexpr int NCHP = 528;
constexpr float EPS = 1e-6f;
constexpr int NWAVES = 8;
#ifndef MK_N_LAUNCHES
#define MK_N_LAUNCHES 1
#endif
constexpr int NPHASE = 14;
#ifndef REP_CONV
#define REP_CONV 1
#endif
#ifndef REP_POOL
#define REP_POOL 1
#endif
#ifndef REP_SSM
#define REP_SSM 1
#endif
#ifndef REP_UP
#define REP_UP 1
#endif
constexpr int N_LAUNCHES = MK_N_LAUNCHES;

constexpr size_t O_YP = 0, O_YS = 33554432, O_PRP = 34078720, O_PRS = 34140160, O_SRP = 34631680, O_SIP = 34648064, O_SRS = 34664448, O_SIS = 34795520, O_END = 34926592;

constexpr size_t MiB = 1u << 20;
constexpr size_t WS_CTL = 0, CTL_ZERO_BYTES = 1 * MiB;
constexpr size_t WS_SS = 512 * 1024;
constexpr size_t WS_WPOOL = 2 * MiB, WS_WGLU = 10 * MiB, WS_WUP0 = 74 * MiB, WS_WUP1 = 202 * MiB, WS_WDN0 = 330 * MiB, WS_WDN1 = 458 * MiB;
constexpr size_t WS_X = 586 * MiB, WS_A0 = 716 * MiB, WS_A1 = 781 * MiB, WS_H = 847 * MiB, WS_SG = 1111 * MiB, WS_HG = 1177 * MiB, WS_SLAB = 1210 * MiB, WS_END = 1242 * MiB;
static_assert((size_t)MROWS * DM * 4 == 130 * MiB && (size_t)MROWS * DM * 2 == 65 * MiB && (size_t)MROWS * DFF * 2 == 260 * MiB, "buffer sizes");
static_assert((size_t)NGRP * NCHP * 128 * 4 == 66 * MiB && (size_t)NGRP * NCHP * 128 * 2 == 33 * MiB, "ssm scratch sizes");
constexpr int CW_Q0 = 128;
constexpr int CW_BAR = 4096;

constexpr int RING_BYTES = 131072, LDS_BYTES = 163840, LDSCTL_OFF = LDS_BYTES - 512, MISC_OFF = LDSCTL_OFF + 320;

__device__ __forceinline__ unsigned f2bf(float f) { unsigned u = __builtin_bit_cast(unsigned, f); return (u + 0x7fffu + ((u >> 16) & 1u)) >> 16; }
__device__ __forceinline__ unsigned pk2(float lo, float hi) { return f2bf(lo) | (f2bf(hi) << 16); }
__device__ __forceinline__ unsigned cvt_pk_bf16(float lo, float hi) { unsigned r; asm volatile("v_cvt_pk_bf16_f32 %0, %1, %2" : "=v"(r) : "v"(lo), "v"(hi)); return r; }
typedef __bf16 bf16x2_t __attribute__((ext_vector_type(2)));
__device__ __forceinline__ unsigned cvt_pk_bf16_c(float lo, float hi) { return __builtin_bit_cast(unsigned, __builtin_convertvector((f32x2){lo, hi}, bf16x2_t)); }
__device__ __forceinline__ float bf_lo(unsigned w) { return __builtin_bit_cast(float, w << 16); }
__device__ __forceinline__ float bf_hi(unsigned w) { return __builtin_bit_cast(float, w & 0xffff0000u); }

namespace pg8 {
constexpr int BM = 256, BK = 64, HALF = 128, HTB = HALF * BK * 2, STAGE_BYTES = 8 * HTB;
__host__ __device__ __forceinline__ int lds_byte(int r, int c) { const int st = (r >> 4) * 2 + (c >> 5), rr = r & 15, cc = c & 31, ob = rr * 64 + cc * 2; return st * 1024 + (ob ^ (((ob >> 9) & 1) << 5)); }
__host__ __device__ __forceinline__ void stage_rc(int b, int& R, int& C) { const int st = b / 1024, sb = b % 1024, swz = sb ^ (((sb >> 9) & 1) << 5); R = (st >> 1) * 16 + swz / 64; C = (st & 1) * 32 + (swz % 64) / 2; }
__host__ __device__ __forceinline__ int perm32(int rho) { const int n = rho >> 4, i = rho & 15; return 8 * (i >> 2) + 4 * n + (i & 3); }

struct Unit { int pm, pn, kind, ks; };
struct Gemm {
    const char* A; const char* Bt;
    unsigned a_rs, a_gs, b_rs;
    int nt_full, nt_split;
    int a_kgrp_pn4;
    unsigned a_ts;
};
struct Sched {
    int nN, G, c, nsplit, nwg;
    __device__ __forceinline__ void init(int nN_, int G_, int c_, int nsplit_) { nN = nN_; G = G_; c = c_; nsplit = nsplit_; nwg = 32 * nN_; }
    __device__ __forceinline__ bool next(int i, Unit& u) const {
        const long L = (long)i * G + c;
        const bool prompt = L < nwg;
        int wgid = prompt ? (int)L : 0; { const int q = nwg / 8, xcd = wgid % 8, off = wgid / 8; wgid = xcd * q + off; }
        const int nig = 8 * nN, gid = wgid / nig, fm = gid * 8;
        const int s = prompt ? 0 : (int)(L - nwg);
        const int pm_ = prompt ? fm + ((wgid % nig) % 8) : 32, pn_ = prompt ? (wgid % nig) / 8 : s / nsplit, kind_ = prompt ? 0 : 1, ks_ = prompt ? 0 : s % nsplit;
        u.pm = pm_; u.pn = pn_; u.kind = kind_; u.ks = ks_;
        return prompt || (L - nwg) < (long)nN * nsplit;
    }
};

template <class Epi>
__device__ __forceinline__ void gemm_phase(LAS unsigned char* lds, const Gemm g, const Sched& S, const Epi& E) {
    const int tid = threadIdx.x, wid = __builtin_amdgcn_readfirstlane(tid >> 6), lane = tid & 63, wr = wid >> 2, wc = wid & 3, fr = lane & 15, fq = lane >> 4;
    unsigned voffA[2], voffB[2];
#pragma unroll
    for (int i = 0; i < 2; ++i) { int R, C; stage_rc(tid * 16 + i * 8192, R, C); const int Rb = Epi::PERM ? ((R & ~31) + perm32(R & 31)) : R;
        voffA[i] = g.a_rs ? (unsigned)R * g.a_rs + (unsigned)(C >> 4) * g.a_gs + (unsigned)(C & 15) * 2u : (unsigned)(tid * 16 + i * 8192); voffB[i] = (unsigned)(tid * 16 + i * 8192); (void)Rb; }
    const size_t akstep = (size_t)g.a_gs * 4, bkstep = (size_t)(2 * HTB);
    const size_t ahstep = g.a_rs ? (size_t)HALF * g.a_rs : (size_t)HTB, bhstep = (size_t)HTB;
    const size_t atstep = g.a_rs ? 2 * ahstep : (size_t)g.a_ts, btstep = (size_t)256 * g.b_rs;
    const unsigned ldsw = (unsigned)wid * 1024u;
    const int aoff = lds_byte(wr * 64 + fr, fq * 8), boff = lds_byte(wc * 32 + fr, fq * 8);
#define PG8_SA(b, h) (((b) * 2 + (h)) * HTB)
#define PG8_SB(b, h) ((4 + (b) * 2 + (h)) * HTB)
#define PG8_STAGE(bufoff, gbase, voff) do { _Pragma("unroll") for (int _i = 0; _i < 2; ++_i) \
        __builtin_amdgcn_global_load_lds((const unsigned*)((const char*)(gbase) + (voff)[_i]), (LAS unsigned*)(lds + (bufoff) + ldsw + _i * 8192), 16, 0, 0); } while (0)
#define PG8_LDA(dst, b, h) do { _Pragma("unroll") for (int m = 0; m < 4; ++m) _Pragma("unroll") for (int k = 0; k < 2; ++k) dst[m][k] = *(const LAS bf16x8*)(lds + PG8_SA(b, h) + aoff + m * 2048 + k * 1024); } while (0)
#define PG8_LDB(dst, b, h) do { _Pragma("unroll") for (int n = 0; n < 2; ++n) _Pragma("unroll") for (int k = 0; k < 2; ++k) dst[n][k] = *(const LAS bf16x8*)(lds + PG8_SB(b, h) + boff + n * 2048 + k * 1024); } while (0)
#define PG8_MMA(ai, bj, At, Bt) do { __builtin_amdgcn_s_setprio(1); _Pragma("unroll") for (int m = 0; m < 4; ++m) _Pragma("unroll") for (int n = 0; n < 2; ++n) _Pragma("unroll") for (int k = 0; k < 2; ++k) \
        acc[ai][bj][m][n] = __builtin_amdgcn_mfma_f32_16x16x32_bf16(Bt[n][k], At[m][k], acc[ai][bj][m][n], 0, 0, 0); __builtin_amdgcn_s_setprio(0); } while (0)
#define PG8_WAIT_V(n) asm volatile("s_waitcnt vmcnt(" #n ")" ::: "memory")
#define PG8_WAIT_L(n) asm volatile("s_waitcnt lgkmcnt(" #n ")" ::: "memory")
#define PG8_BAR __builtin_amdgcn_s_barrier()
#define PG8_SCHED __builtin_amdgcn_sched_barrier(0)
#define PG8_UNIT_PTRS(u, pA, pB, hs, ntu) do { const int _nt = (u).kind ? g.nt_split : g.nt_full; \
        pA = g.A + (size_t)(u).pm * atstep + ((size_t)((u).pn >> 2) * g.a_kgrp_pn4 + (size_t)(u).ks * _nt * 4) * g.a_gs; \
        pB = g.Bt + (size_t)(u).pn * btstep + (size_t)(u).ks * _nt * bkstep; hs = (u).kind ? (size_t)0 : ahstep; ntu = _nt; } while (0)
    Unit cur, nxt; int ui = 0; bool st16 = false;
    if (!S.next(0, cur)) return;
    f32x4 acc[2][2][4][2];
#pragma unroll
    for (int a = 0; a < 2; ++a)
#pragma unroll
        for (int b = 0; b < 2; ++b)
#pragma unroll
            for (int m = 0; m < 4; ++m)
#pragma unroll
                for (int n = 0; n < 2; ++n) acc[a][b][m][n] = (f32x4){0.f, 0.f, 0.f, 0.f};
    bf16x8 At[4][2], B0[2][2], B1[2][2];
    const char* cA; const char* cB; size_t cH; int nt;
    PG8_UNIT_PTRS(cur, cA, cB, cH, nt);
    PG8_STAGE(PG8_SB(0, 0), cB, voffB); PG8_STAGE(PG8_SB(0, 1), cB + bhstep, voffB); PG8_STAGE(PG8_SA(0, 0), cA, voffA); PG8_STAGE(PG8_SA(0, 1), cA + cH, voffA);
    if (wr == 1) PG8_BAR;
    PG8_WAIT_V(2); PG8_BAR;
    PG8_STAGE(PG8_SB(1, 0), cB + bkstep, voffB); PG8_STAGE(PG8_SA(1, 0), cA + akstep, voffA); PG8_STAGE(PG8_SB(1, 1), cB + bhstep + bkstep, voffB);
    PG8_WAIT_V(6); PG8_BAR;
    for (;;) {
        const bool has_next = S.next(ui + 1, nxt);
        const char* nA = cA; const char* nB = cB; size_t nH = cH; int nnt = nt;
        if (has_next) PG8_UNIT_PTRS(nxt, nA, nB, nH, nnt);
#define PG8_ITER(FULL, W1, W2) { \
            const bool last = (t == nt - 2); \
            const char* a1 = cA + (size_t)(t + 1) * akstep; \
            const char* a2 = last ? nA : cA + (size_t)(t + 2) * akstep; const char* b2 = last ? nB : cB + (size_t)(t + 2) * bkstep; \
            const size_t h2 = last ? nH : cH; \
            const char* a3 = a2 + akstep; const char* b3 = b2 + bkstep; \
              \
            PG8_LDB(B0, 0, 0); PG8_LDB(B1, 0, 1); PG8_SCHED; PG8_LDA(At, 0, 0); PG8_STAGE(PG8_SA(1, 1), a1 + cH, voffA); \
            PG8_WAIT_V(W1); PG8_WAIT_L(0); PG8_BAR; PG8_MMA(0, 0, At, B0); PG8_MMA(0, 1, At, B1); PG8_BAR; PG8_SCHED; \
              \
            if (FULL) PG8_LDA(At, 0, 1); PG8_STAGE(PG8_SB(0, 0), b2, voffB); PG8_STAGE(PG8_SB(0, 1), b2 + bhstep, voffB); PG8_STAGE(PG8_SA(0, 0), a2, voffA); \
            PG8_WAIT_V(W2); PG8_WAIT_L(0); PG8_BAR; if (FULL) { PG8_MMA(1, 0, At, B0); PG8_MMA(1, 1, At, B1); } PG8_BAR; PG8_SCHED; \
              \
            PG8_LDB(B0, 1, 0); PG8_LDB(B1, 1, 1); PG8_SCHED; PG8_LDA(At, 1, 0); PG8_STAGE(PG8_SA(0, 1), a2 + h2, voffA); \
            PG8_WAIT_V(8); PG8_WAIT_L(0); PG8_BAR; PG8_MMA(0, 0, At, B0); PG8_MMA(0, 1, At, B1); PG8_BAR; PG8_SCHED; \
              \
            if (FULL) PG8_LDA(At, 1, 1); PG8_STAGE(PG8_SB(1, 0), b3, voffB); PG8_STAGE(PG8_SB(1, 1), b3 + bhstep, voffB); PG8_STAGE(PG8_SA(1, 0), a3, voffA); \
            PG8_WAIT_V(8); PG8_WAIT_L(0); PG8_BAR; if (FULL) { PG8_MMA(1, 0, At, B0); PG8_MMA(1, 1, At, B1); } PG8_BAR; PG8_SCHED; }
#define PG8_KLOOP(FULL) { for (int t = 0; t < nt; t += 2) PG8_ITER(FULL, 8, 8) }
        if (cur.kind == 0) PG8_KLOOP(true) else PG8_KLOOP(false)
#undef PG8_KLOOP
#undef PG8_ITER
        if (wr == 0) PG8_BAR;
        E(acc, cur, wr, wc, fr, fq);
        if (!has_next) break;
#pragma unroll
        for (int a = 0; a < 2; ++a)
#pragma unroll
            for (int b = 0; b < 2; ++b)
#pragma unroll
                for (int m = 0; m < 4; ++m)
#pragma unroll
                    for (int n = 0; n < 2; ++n) acc[a][b][m][n] = (f32x4){0.f, 0.f, 0.f, 0.f};
        st16 = Epi::ST16 || cur.kind != 0;
        cur = nxt; cA = nA; cB = nB; cH = nH; nt = nnt; ++ui;
        if (wr == 1) PG8_BAR;
    }
    PG8_WAIT_V(0);
    PG8_BAR;
#undef PG8_SA
#undef PG8_SB
#undef PG8_STAGE
#undef PG8_LDA
#undef PG8_LDB
#undef PG8_MMA
#undef PG8_WAIT_V
#undef PG8_WAIT_L
#undef PG8_BAR
#undef PG8_SCHED
#undef PG8_UNIT_PTRS
}
}

__device__ __forceinline__ size_t tiled_off(int row, int col, int nkt) { return (((size_t)(row >> 8) * nkt + (col >> 6)) * 2 + ((row >> 7) & 1)) * (size_t)pg8::HTB + pg8::lds_byte(row & 127, col & 63); }
struct EpiArgs {
    const float* xin_p; const float* xin_s; const bf16_t* Rin; bf16_t* Aout; bf16_t* H; float* outy; const float* vec; const float* ss_in; float* ss_out; bf16_t* slab; int slab_ld;
};
__device__ __forceinline__ float sigmoidf_(float x) { return __builtin_amdgcn_rcpf(1.0f + __expf(-x)); }
template <int MODE> struct Epi {
    static constexpr bool PERM = true, ST16 = (MODE == 2);
    EpiArgs a;
    __device__ __forceinline__ void operator()(const f32x4 (&acc)[2][2][4][2], const pg8::Unit& u, int wr, int wc, int fr, int fq) const {
        const int colb = u.pn * 256 + wc * 32 + 8 * fq;
        if (u.kind != 0) {
            bf16_t* sl = a.slab + (size_t)u.ks * NSAMP * a.slab_ld + colb;
#pragma unroll
            for (int m = 0; m < 4; ++m) { bf16_t* rp = sl + (size_t)(wr * 64 + m * 16 + fr) * a.slab_ld;
#pragma unroll
                for (int bj = 0; bj < 2; ++bj) { const f32x4 v0 = acc[0][bj][m][0], v1 = acc[0][bj][m][1];
                    u32x4 w; w.x = cvt_pk_bf16_c(v0[0], v0[1]); w.y = cvt_pk_bf16_c(v0[2], v0[3]); w.z = cvt_pk_bf16_c(v1[0], v1[1]); w.w = cvt_pk_bf16_c(v1[2], v1[3]);
                    *(u32x4*)(rp + 128 * bj) = w; } }
            return;
        }
#define SSQ8(v0, v1) ((v0[0] * v0[0] + v0[1] * v0[1]) + (v0[2] * v0[2] + v0[3] * v0[3]) + (v1[0] * v1[0] + v1[1] * v1[1]) + (v1[2] * v1[2] + v1[3] * v1[3]))
        float rs8[2][4];
        if constexpr (MODE == 2) {
#pragma unroll
            for (int ai = 0; ai < 2; ++ai)
#pragma unroll
                for (int m = 0; m < 4; ++m) rs8[ai][m] = a.ss_in[u.pm * 256 + ai * 128 + wr * 64 + fr + 16 * m]; }
#pragma unroll
        for (int ai = 0; ai < 2; ++ai) {
            const int gr0 = u.pm * 256 + ai * 128 + wr * 64 + fr;
            if constexpr (MODE == 2) {
#pragma unroll
                for (int m = 0; m < 4; ++m) { const float r = __builtin_amdgcn_rsqf(rs8[ai][m] * (1.0f / DM) + EPS);
#pragma unroll
                    for (int bj = 0; bj < 2; ++bj) { const int col = colb + 128 * bj;
                        f32x4 v0 = acc[ai][bj][m][0] * r, v1 = acc[ai][bj][m][1] * r;
#pragma unroll
                        for (int j = 0; j < 4; ++j) { const float p0 = fmaxf(v0[j], 0.f), p1 = fmaxf(v1[j], 0.f); v0[j] = p0 * p0; v1[j] = p1 * p1; }
                        u32x4 w; w.x = cvt_pk_bf16(v0[0], v0[1]); w.y = cvt_pk_bf16(v0[2], v0[3]); w.z = cvt_pk_bf16(v1[0], v1[1]); w.w = cvt_pk_bf16(v1[2], v1[3]);
                        *(u32x4*)((char*)a.H + tiled_off(gr0 + 16 * m, col, DFF / 64)) = w; } }
            } else {
                const int col4 = u.pn * 128 + wc * 32 + 8 * fq;
                f32x4 vs[2][2];
                if constexpr (MODE == 1) {
#pragma unroll
                    for (int bj = 0; bj < 2; ++bj) { vs[bj][0] = *(const f32x4*)(a.vec + colb + 128 * bj); vs[bj][1] = *(const f32x4*)(a.vec + colb + 128 * bj + 4); } }
                constexpr int NBJ = (MODE == 4) ? 1 : 2;
                constexpr int MB = (MODE == 1) ? 2 : 4;
#pragma unroll
                for (int mh = 0; mh < 4 / MB; ++mh) {
                    f32x4 xf[MODE == 1 ? MB : 1][2][2]; u32x4 xr4[MODE == 1 ? 1 : MB][NBJ];
#pragma unroll
                    for (int mm = 0; mm < MB; ++mm) { const int gr = gr0 + 16 * (MB * mh + mm);
#pragma unroll
                        for (int bj = 0; bj < NBJ; ++bj) {
                            if constexpr (MODE == 1) { const float* xr = ((gr < SEQ) ? a.xin_p + (size_t)gr * DM : a.xin_s + (size_t)(gr - SEQ) * DM) + colb + 128 * bj; xf[mm][bj][0] = *(const f32x4*)xr; xf[mm][bj][1] = *(const f32x4*)(xr + 4); }
                            else { const int col = (MODE == 4) ? col4 : colb + 128 * bj;
                                xr4[mm][bj] = (MODE == 4) ? *(const u32x4*)(a.Rin + ((size_t)(col >> 4) * MROWS + gr) * 16 + (col & 15)) : *(const u32x4*)((const char*)a.Rin + tiled_off(gr, col, DM / 64)); } } }
#pragma unroll
                    for (int mm = 0; mm < MB; ++mm) { const int m = MB * mh + mm, gr = gr0 + 16 * m; float ss = 0.f;
#pragma unroll
                        for (int bj = 0; bj < NBJ; ++bj) { const int col = (MODE == 4) ? col4 : colb + 128 * bj;
                            f32x4 v0, v1;
                            if constexpr (MODE == 1) { v0 = xf[mm][bj][0] + vs[bj][0] * acc[ai][bj][m][0]; v1 = xf[mm][bj][1] + vs[bj][1] * acc[ai][bj][m][1]; }
                            else { const u32x4 rw = xr4[mm][bj]; v0 = (f32x4){bf_lo(rw.x), bf_hi(rw.x), bf_lo(rw.y), bf_hi(rw.y)}; v1 = (f32x4){bf_lo(rw.z), bf_hi(rw.z), bf_lo(rw.w), bf_hi(rw.w)};
                                if constexpr (MODE == 4) {
#pragma unroll
                                    for (int j = 0; j < 4; ++j) { v0[j] += acc[ai][0][m][0][j] * sigmoidf_(acc[ai][1][m][0][j]); v1[j] += acc[ai][0][m][1][j] * sigmoidf_(acc[ai][1][m][1][j]); } }
                                else { v0 += acc[ai][bj][m][0]; v1 += acc[ai][bj][m][1]; } }
                            ss += SSQ8(v0, v1);
                            u32x4 w; w.x = cvt_pk_bf16(v0[0], v0[1]); w.y = cvt_pk_bf16(v0[2], v0[3]); w.z = cvt_pk_bf16(v1[0], v1[1]); w.w = cvt_pk_bf16(v1[2], v1[3]);
                            if constexpr (MODE == 3) *(u32x4*)(a.Aout + ((size_t)(col >> 4) * MROWS + gr) * 16 + (col & 15)) = w;
                            else if constexpr (MODE == 5) *(u32x4*)(a.Aout + (size_t)gr * DM + col) = w;
                            else *(u32x4*)((char*)a.Aout + tiled_off(gr, col, DM / 64)) = w;
                        }
                        ss += __shfl_xor(ss, 16); ss += __shfl_xor(ss, 32);
                        if (fq == 0) unsafeAtomicAdd(a.ss_out + gr, ss); }
                }
            }
        }
#undef SSQ8
    }
};

typedef GAS unsigned gu32;
#define RLX_AGENT __ATOMIC_RELAXED, __HIP_MEMORY_SCOPE_AGENT
#define XB_TMO      128
#define XB_XCNT(j)  (256  + 64 * (j))
#define XB_XSUB(j)  (1280 + 64 * (j))
#define XB_XGEN(j)  (2304 + 64 * (j))
#define XB_TOP      3328
#define XB_TOPGEN   3392
#define XCD_BAR_WORDS 3456
#define XB_SPIN_CAP (1u << 18)
__device__ __forceinline__ unsigned xb_ld(unsigned* p)              { return __hip_atomic_load(p, __ATOMIC_RELAXED, __HIP_MEMORY_SCOPE_AGENT); }
__device__ __forceinline__ unsigned xb_add(unsigned* p, unsigned v) { return __hip_atomic_fetch_add(p, v, __ATOMIC_RELAXED, __HIP_MEMORY_SCOPE_AGENT); }
__device__ __forceinline__ unsigned xb_xcc_id() { return (unsigned)__builtin_amdgcn_s_getreg((3 << 11) | 20) & 0xFu; }
#define XB_SPIN(cond, bar) do { unsigned _sp = 0; while (cond) { __builtin_amdgcn_s_sleep(1); \
    if ((++_sp & 255u) == 0u) { if (xb_ld(&(bar)[XB_TMO])) break; if (_sp > XB_SPIN_CAP) { atomicAdd(&(bar)[XB_TMO], 1u); break; } } } } while (0)
struct XcdBarrier { unsigned* bar; unsigned x; volatile LAS unsigned* st; };
__device__ __forceinline__ XcdBarrier xcd_barrier_post(unsigned* bar, volatile LAS unsigned* st) {
    XcdBarrier b; b.bar = bar; b.x = xb_xcc_id(); b.st = st;
    if (threadIdx.x == 0) (void)xb_add(&bar[XB_XCNT(b.x)], 1u);
    return b;
}
__device__ __forceinline__ void xcd_barrier_complete(unsigned* bar, unsigned x, unsigned& nloc, unsigned& nx) {
    const unsigned G = gridDim.x * gridDim.y * gridDim.z;
    unsigned sum, cnt, mine, sp = 0u;
    for (;;) {
        sum = 0u; cnt = 0u; mine = 0u;
#pragma unroll
        for (unsigned j = 0; j < 16; ++j) { const unsigned c = xb_ld(&bar[XB_XCNT(j)]); sum += c; cnt += (c > 0u) ? 1u : 0u; mine = (j == x) ? c : mine; }
        if (sum == G) break;
        __builtin_amdgcn_s_sleep(1);
        if ((++sp & 255u) == 0u) { if (xb_ld(&bar[XB_TMO])) break; if (sp > XB_SPIN_CAP) { atomicAdd(&bar[XB_TMO], 1u); break; } }
    }
    nloc = mine > 0u ? mine : 1u; nx = cnt > 0u ? cnt : 1u;
}
__device__ __forceinline__ void xcd_barrier(const XcdBarrier& b) {
    asm volatile("s_waitcnt vmcnt(0)" ::: "memory");
    __syncthreads();
    if (threadIdx.x == 0) {
        unsigned* bar = b.bar;
        __builtin_amdgcn_s_waitcnt(0);
        unsigned nloc = b.st[0], nx = b.st[1];
        if (nloc == 0u) { xcd_barrier_complete(bar, b.x, nloc, nx); b.st[0] = nloc; b.st[1] = nx; }
        const unsigned old = xb_add(&bar[XB_XSUB(b.x)], 1u);
        const unsigned gen = old / nloc;
        if (old + 1u == (gen + 1u) * nloc) {
            __builtin_amdgcn_fence(__ATOMIC_RELEASE, "agent");
            asm volatile("s_waitcnt vmcnt(0)" ::: "memory");
            const unsigned og = xb_add(&bar[XB_TOP], 1u);
            const unsigned tg = og / nx;
            if (og + 1u == (tg + 1u) * nx) xb_add(&bar[XB_TOPGEN], 1u);
            else XB_SPIN(xb_ld(&bar[XB_TOPGEN]) == tg, bar);
            __builtin_amdgcn_fence(__ATOMIC_ACQUIRE, "agent");
            xb_add(&bar[XB_XGEN(b.x)], 1u);
            asm volatile("s_waitcnt vmcnt(0)" ::: "memory");
        } else {
            XB_SPIN(xb_ld(&bar[XB_XGEN(b.x)]) == gen, bar);
            __builtin_amdgcn_fence(__ATOMIC_ACQUIRE, "agent");
            asm volatile("s_waitcnt vmcnt(0)" ::: "memory");
        }
    }
    __syncthreads();
}

struct Args { const float* in[22]; float* out; unsigned char* ws; int ph_lo, ph_hi; };
struct Frame {
    LAS unsigned char* lds; int tid, lane, wave, vcu, G;
};
__device__ __forceinline__ float wave_sum(float v) {
#pragma unroll
    for (int o = 1; o < 64; o <<= 1) v += __shfl_xor(v, o);
    return v;
}

__device__ __forceinline__ unsigned q_grab(unsigned* ctr) { return __hip_atomic_fetch_add(ctr, 1u, __ATOMIC_RELAXED, __HIP_MEMORY_SCOPE_AGENT); }
__device__ __forceinline__ unsigned q_next(Frame& F, volatile LAS unsigned* qw, unsigned* ctr, unsigned& pend) {
    if (F.tid == 0) { *qw = pend; pend = q_grab(ctr); }
    __syncthreads();
    const unsigned v = *qw;
    __syncthreads();
    return (unsigned)__builtin_amdgcn_readfirstlane((int)v);
}
constexpr int T0_PITCH = 264;
struct T0Tile { const float* W; int K, N; const float* gk; bf16_t* D; int drow0, k0, n0; };
__device__ __forceinline__ void t0_load(Frame& F, const T0Tile& t, float (&v)[16][2]) {
    const float* src = t.W + (size_t)(t.k0 + F.wave * 16) * t.N + t.n0 + F.lane;
#pragma unroll
    for (int i = 0; i < 16; ++i) { v[i][0] = src[(size_t)i * t.N]; v[i][1] = src[(size_t)i * t.N + 64]; }
}
__device__ __forceinline__ unsigned t0_store(Frame& F, const T0Tile& t, const float (&v)[16][2], volatile LAS unsigned* qw, unsigned* ctr, unsigned& pend) {
#pragma unroll
    for (int i = 0; i < 8; ++i) {
        const int kk = F.wave * 16 + 2 * i;
        const float g0 = t.gk ? t.gk[t.k0 + kk] : 1.f, g1 = t.gk ? t.gk[t.k0 + kk + 1] : 1.f;
#pragma unroll
        for (int j = 0; j < 2; ++j) *(LAS unsigned*)(F.lds + (F.lane + 64 * j) * T0_PITCH + kk * 2) = pk2(v[2 * i][j] * g0, v[2 * i + 1][j] * g1);
    }
    if (F.tid == 0) { *qw = pend; pend = q_grab(ctr); }
    __syncthreads();
    const unsigned nxt = *qw;
    const int n = F.tid >> 2, c = F.tid & 3;
#pragma unroll
    for (int i = 0; i < 4; ++i) {
        const int off = i * 64 + c * 16;
        const u32x2 lo = *(const LAS u32x2*)(F.lds + n * T0_PITCH + off), hi = *(const LAS u32x2*)(F.lds + n * T0_PITCH + off + 8);
        u32x4 w; w.x = lo.x; w.y = lo.y; w.z = hi.x; w.w = hi.y;
        const int gn = t.drow0 + n, rw = gn & 127, w5 = rw & 31, R = (rw & ~31) + 16 * ((w5 >> 2) & 1) + 4 * (w5 >> 3) + (w5 & 3), kk = t.k0 + (off >> 1);
        const size_t tile = ((size_t)(gn >> 8) * (t.K >> 6) + (kk >> 6)) * 2 + ((gn >> 7) & 1);
        *(u32x4*)((char*)t.D + tile * 16384 + pg8::lds_byte(R, kk & 63)) = w;
    }
    __syncthreads();
    return (unsigned)__builtin_amdgcn_readfirstlane((int)nxt);
}

__device__ __forceinline__ void t1_unit(Frame& F, const Args& args, int un, bf16_t* A0) {
    const float* xp = args.in[0]; const float* xs = args.in[1]; const float* cache = args.in[2]; const float* g0p = args.in[5];
    const bool samp = un >= SEQ / 16; const int b = un - SEQ / 16, t0 = samp ? 0 : un * 16;
    LAS float* rs = (LAS float*)(F.lds);
    for (int e = F.wave; e < 31; e += NWAVES) {
        const int t = t0 - 15 + e; float r = 0.f;
        if (t >= 0) { const float* xr = samp ? xs + ((size_t)b * LS + t) * DM : xp + (size_t)t * DM; float s = 0.f;
#pragma unroll 4
            for (int j = 0; j < 16; ++j) { const f32x4 q = *(const f32x4*)(xr + j * 256 + F.lane * 4); s += (q[0] * q[0] + q[1] * q[1]) + (q[2] * q[2] + q[3] * q[3]); }
            r = 1.0f / sqrtf(wave_sum(s) * (1.0f / DM) + EPS); }
        if (F.lane == 0) rs[e] = r;
    }
    __syncthreads();
    const int ch0 = F.tid * 8, w = 2 << (F.tid >> 7);
    const f32x4 ga = *(const f32x4*)(g0p + ch0), gb = *(const f32x4*)(g0p + ch0 + 4);
#define T1_FETCH(e, o0, o1) do { const int _t = t0 - 15 + (e); \
        if (_t >= 0) { const float* _xr = (samp ? xs + ((size_t)b * LS + _t) * DM : xp + (size_t)_t * DM) + ch0; const float _r = rs[(e)]; \
            o0 = *(const f32x4*)_xr * _r * ga; o1 = *(const f32x4*)(_xr + 4) * _r * gb; } \
        else if (samp) { const float* _hr = cache + ((size_t)b * 15 + (e)) * DM + ch0; o0 = *(const f32x4*)_hr; o1 = *(const f32x4*)(_hr + 4); } \
        else { o0 = (f32x4){0.f, 0.f, 0.f, 0.f}; o1 = o0; } } while (0)
    f32x4 s0 = (f32x4){0.f, 0.f, 0.f, 0.f}, s1 = s0;
    for (int e = 16 - w; e < 15; ++e) { f32x4 q0, q1; T1_FETCH(e, q0, q1); s0 += q0; s1 += q1; }
    for (int r = 0; r < 16; ++r) {
        const int e = 15 + r, t = t0 + r; f32x4 c0, c1; T1_FETCH(e, c0, c1); s0 += c0; s1 += c1;
        const float inv = 1.0f / (float)(samp ? w : (t + 1 < w ? t + 1 : w));
        const f32x4 p0 = s0 * inv - c0, p1 = s1 * inv - c1;
        const size_t gr = samp ? (size_t)SEQ + b * LS + t : (size_t)t;
        u32x4 o; o.x = pk2(p0[0], p0[1]); o.y = pk2(p0[2], p0[3]); o.z = pk2(p1[0], p1[1]); o.w = pk2(p1[2], p1[3]);
        *(u32x4*)(A0 + gr * DM + ch0) = o;
        if (samp) { if (r >= 1) { float* po = args.out + O_PRS + ((size_t)b * 15 + (r - 1)) * DM + ch0; *(f32x4*)po = c0; *(f32x4*)(po + 4) = c1; } }
        else if (t >= SEQ - 15) { float* po = args.out + O_PRP + (size_t)(t - (SEQ - 15)) * DM + ch0; *(f32x4*)po = c0; *(f32x4*)(po + 4) = c1; }
        f32x4 q0, q1; T1_FETCH(e - w + 1, q0, q1); s0 -= q0; s1 -= q1;
    }
#undef T1_FETCH
    __syncthreads();
}

constexpr int L_AP = 0, L_APT = 8704, L_BB = 17408, L_CC = 25600, L_CCT = 33792, L_KT = 41984, L_DD = 50176, L_XW = 50432, L_RS = 54528, L_TAB = 87808;
constexpr int FT_PITCH = 528, ET_PITCH = 272;
static_assert(L_TAB + 256 * ET_PITCH <= LDSCTL_OFF && L_TAB + 128 * FT_PITCH <= LDSCTL_OFF, "SSM LDS map");
__device__ __forceinline__ f32x2 cmul(f32x2 a, f32x2 b) { return (f32x2){a.x * b.x - a.y * b.y, a.x * b.y + a.y * b.x}; }
__device__ __forceinline__ float gelu_tanh(float x) {
    const float z = 0.7978845608028654f * (x + 0.044715f * x * x * x);
    const float e = __expf(2.0f * z);
    const float th = 1.0f - 2.0f * __builtin_amdgcn_rcpf(1.0f + e);
    return 0.5f * x * (1.0f + th);
}
__device__ __forceinline__ void ssm_load_u(const bf16_t* Ug, int mt, int fr, int q, u32x4 (&raw)[8]) {
    const int chunk = mt * 16 + fr; const bool valid = chunk < NCHUNK;
#pragma unroll
    for (int ks = 0; ks < 8; ++ks) raw[ks] = valid ? *(const u32x4*)(Ug + ((size_t)chunk * 16 + 2 * ks + (q >> 1)) * 16 + (q & 1) * 8) : (u32x4){0u, 0u, 0u, 0u};
}
__device__ __forceinline__ void ssm_load_h(const unsigned* Hg, int mt, int fr, int q, u32x4 (&hw)[4]) {
    const int chunk = mt * 16 + fr; const bool valid = chunk < NCHUNK;
#pragma unroll
    for (int kh = 0; kh < 4; ++kh) hw[kh] = valid ? *(const u32x4*)(Hg + (size_t)chunk * 64 + kh * 16 + q * 4) : (u32x4){0u, 0u, 0u, 0u};
}
__device__ __forceinline__ bf16x8 ssm_scale(const u32x4 raw, float r, const float (&g8)[8]) {
    u32x4 w; w.x = cvt_pk_bf16_c(bf_lo(raw.x) * (r * g8[0]), bf_hi(raw.x) * (r * g8[1])); w.y = cvt_pk_bf16_c(bf_lo(raw.y) * (r * g8[2]), bf_hi(raw.y) * (r * g8[3]));
    w.z = cvt_pk_bf16_c(bf_lo(raw.z) * (r * g8[4]), bf_hi(raw.z) * (r * g8[5])); w.w = cvt_pk_bf16_c(bf_lo(raw.w) * (r * g8[6]), bf_hi(raw.w) * (r * g8[7]));
    return __builtin_bit_cast(bf16x8, w);
}
__device__ __forceinline__ void ssm_s_tile(const u32x4 (&raw)[8], const float (&g8)[8], int mt, int fr, int q, const LAS float* RS, const LAS unsigned char* TAB, unsigned* Sg) {
    const int chunk = mt * 16 + fr; const bool valid = chunk < NCHUNK;
    f32x4 acc[8];
#pragma unroll
    for (int i = 0; i < 8; ++i) acc[i] = (f32x4){0.f, 0.f, 0.f, 0.f};
#pragma unroll
    for (int ks = 0; ks < 8; ++ks) {
        const bf16x8 af = ssm_scale(raw[ks], valid ? RS[chunk * 16 + 2 * ks + (q >> 1)] : 0.f, g8);
#pragma unroll
        for (int nt = 0; nt < 8; ++nt) { const bf16x8 bfr = *(const LAS bf16x8*)(TAB + (nt * 16 + fr) * FT_PITCH + (ks * 32 + q * 8) * 2);
            acc[nt] = __builtin_amdgcn_mfma_f32_16x16x32_bf16(bfr, af, acc[nt], 0, 0, 0); }
    }
    asm volatile("s_nop 7\n\ts_nop 7" : "+v"(acc[0]), "+v"(acc[1]), "+v"(acc[2]), "+v"(acc[3]), "+v"(acc[4]), "+v"(acc[5]), "+v"(acc[6]), "+v"(acc[7]));
#pragma unroll
    for (int nt = 0; nt < 4; ++nt) { u32x4 w;
        w.x = cvt_pk_bf16(acc[nt][0], acc[nt + 4][0]); w.y = cvt_pk_bf16(acc[nt][1], acc[nt + 4][1]); w.z = cvt_pk_bf16(acc[nt][2], acc[nt + 4][2]); w.w = cvt_pk_bf16(acc[nt][3], acc[nt + 4][3]);
        *(u32x4*)(Sg + (size_t)chunk * 64 + nt * 16 + q * 4) = w; }
}
__device__ __forceinline__ void ssm_y_tile(const u32x4 (&raw)[8], const float (&g8)[8], const unsigned* Hg, int mt, int fr, int q, const LAS float* RS, const LAS bf16_t* KT, const LAS unsigned char* ET, bf16_t* Yg) {
    const int chunk = mt * 16 + fr; const bool valid = chunk < NCHUNK;
    u32x4 hw[4]; ssm_load_h(Hg, mt, fr, q, hw);
    f32x4 acc[16];
#pragma unroll
    for (int i = 0; i < 16; ++i) acc[i] = (f32x4){0.f, 0.f, 0.f, 0.f};
#pragma unroll
    for (int ks = 0; ks < 8; ++ks) {
        const int s = 2 * ks + (q >> 1), c0 = (q & 1) * 8;
        const bf16x8 af = ssm_scale(raw[ks], valid ? RS[chunk * 16 + s] : 0.f, g8);
#pragma unroll
        for (int j = 2 * ks; j < 16; ++j) {
            const int d = j - s;
            u32x4 bw = *(const LAS u32x4*)(KT + ((d < 0 ? 0 : d) * 256 + fr * 16 + c0));
            if (d < 0) bw = (u32x4){0u, 0u, 0u, 0u};
            acc[j] = __builtin_amdgcn_mfma_f32_16x16x32_bf16(__builtin_bit_cast(bf16x8, bw), af, acc[j], 0, 0, 0);
            if ((j & 3) == 3) __builtin_amdgcn_sched_barrier(0);
        }
    }
#pragma unroll
    for (int kh = 0; kh < 4; ++kh) {
        const bf16x8 af = __builtin_bit_cast(bf16x8, hw[kh]);
#pragma unroll
        for (int j = 0; j < 16; ++j) { const bf16x8 bfr = *(const LAS bf16x8*)(ET + (j * 16 + fr) * ET_PITCH + (kh * 32 + q * 8) * 2);
            acc[j] = __builtin_amdgcn_mfma_f32_16x16x32_bf16(bfr, af, acc[j], 0, 0, 0);
            if ((j & 3) == 3) __builtin_amdgcn_sched_barrier(0); }
    }
    if (valid) {
#pragma unroll
        for (int j = 0; j < 16; ++j) { u32x2 o; o.x = cvt_pk_bf16(gelu_tanh(acc[j][0]), gelu_tanh(acc[j][1])); o.y = cvt_pk_bf16(gelu_tanh(acc[j][2]), gelu_tanh(acc[j][3]));
            *(u32x2*)(Yg + ((size_t)chunk * 16 + j) * 16 + q * 4) = o; }
    }
}
__device__ __forceinline__ void ssm_group(Frame& F, const Args& args, int g, const bf16_t* UgAll, bf16_t* YgAll, const float* ss, unsigned* SgAll, unsigned* HgAll) {
    LAS f32x2* AP = (LAS f32x2*)(F.lds + L_AP);
    LAS f32x2* APT = (LAS f32x2*)(F.lds + L_APT);
    LAS f32x2* BB = (LAS f32x2*)(F.lds + L_BB);
    LAS f32x2* CC = (LAS f32x2*)(F.lds + L_CC);
    LAS f32x2* CCT = (LAS f32x2*)(F.lds + L_CCT);
    LAS bf16_t* KT = (LAS bf16_t*)(F.lds + L_KT);
    LAS float* DD = (LAS float*)(F.lds + L_DD);
    LAS f32x2* XW = (LAS f32x2*)(F.lds + L_XW);
    LAS float* RS = (LAS float*)(F.lds + L_RS);
    LAS unsigned char* TAB = F.lds + L_TAB;
    const bf16_t* Ug = UgAll + (size_t)g * MROWS * 16; bf16_t* Yg = YgAll + (size_t)g * MROWS * 16;
    unsigned* Sg = SgAll + (size_t)g * NCHP * 64; unsigned* Hg = HgAll + (size_t)g * NCHP * 64;
    const int tid = F.tid, lane = F.lane, wave = F.wave, fr = lane & 15, q = lane >> 4;
    float g8[8];
#pragma unroll
    for (int i = 0; i < 8; ++i) g8[i] = args.in[5][DM + g * CG + (q & 1) * 8 + i];
    {
        const float dt = expf(args.in[10][g]);
        for (int e = tid; e < 17 * PST; e += NWAVES * 64) { const int tau = e >> 6, p = e & 63;
            const float are = args.in[8][g * PST + p], aim = args.in[9][g * PST + p];
            double ang = (double)aim * (double)dt * (double)tau; ang -= 6.283185307179586 * floor(ang * 0.15915494309189535);
            float sn, cs; sincosf((float)ang, &sn, &cs); const float mag = expf(are * dt * (float)tau);
            const f32x2 v = (f32x2){mag * cs, mag * sn}; AP[e] = v; APT[p * 17 + tau] = v; }
        if (tid < PST) { const int p = tid;
            const float are = args.in[8][g * PST + p], aim = args.in[9][g * PST + p]; const f32x2 z = (f32x2){are * dt, aim * dt}; f32x2 qv;
            if (z.x * z.x + z.y * z.y < 0.0625f) { f32x2 h = (f32x2){1.f, 0.f};
#pragma unroll
                for (int k = 8; k >= 2; --k) { h = cmul(z, h); h.x = 1.f + h.x * (1.0f / k); h.y = h.y * (1.0f / k); }
                qv = (f32x2){dt * h.x, dt * h.y};
            } else { float sn, cs; sincosf(z.y, &sn, &cs); const float mag = expf(z.x); const float nr = mag * cs - 1.0f, ni = mag * sn, den = 1.0f / (are * are + aim * aim);
                qv = (f32x2){(nr * are + ni * aim) * den, (ni * are - nr * aim) * den}; }
            XW[p] = qv; }
        for (int e = tid; e < CG * PST; e += NWAVES * 64) { const f32x2 v = (f32x2){args.in[13][(size_t)g * CG * PST + e], args.in[14][(size_t)g * CG * PST + e]}; CC[e] = v; CCT[(e & 63) * 16 + (e >> 6)] = v; }
        if (tid < CG) DD[tid] = args.in[15][g * CG + tid];
        for (int e = tid; e < MROWS; e += NWAVES * 64) RS[e] = __builtin_amdgcn_rsqf(ss[e] * (1.0f / DM) + EPS);
        __syncthreads();
        for (int e = tid; e < PST * CG; e += NWAVES * 64) { const int p = e >> 4;
            BB[e] = cmul(XW[p], (f32x2){args.in[11][(size_t)g * PST * CG + e], args.in[12][(size_t)g * PST * CG + e]}); }
    }
    __syncthreads();
    {
        const int tau = tid >> 5, c = (tid >> 1) & 15, c0 = (tid & 1) * 8; float k8[8];
#pragma unroll
        for (int i = 0; i < 8; ++i) k8[i] = (tau == 0 && c == c0 + i) ? DD[c] : 0.f;
        for (int p = 0; p < PST; ++p) { const f32x2 m = cmul(CCT[p * 16 + c], AP[tau * 64 + p]);
#pragma unroll
            for (int i = 0; i < 8; ++i) { const f32x2 bb = BB[p * 16 + c0 + i]; k8[i] += m.x * bb.x - m.y * bb.y; } }
        u32x4 w; w.x = pk2(k8[0], k8[1]); w.y = pk2(k8[2], k8[3]); w.z = pk2(k8[4], k8[5]); w.w = pk2(k8[6], k8[7]);
        *(LAS u32x4*)(KT + (tau * 256 + c * 16 + c0)) = w;
        for (int e = tid; e < 128 * 128; e += NWAVES * 64) {
            const int n = e >> 7, k = (e & 127) * 2, p = n & 63, s = k >> 4, cp = k & 15;
            const f32x2 ap = APT[p * 17 + 15 - s], v0 = cmul(ap, BB[p * 16 + cp]), v1 = cmul(ap, BB[p * 16 + cp + 1]);
            *(LAS unsigned*)(TAB + n * FT_PITCH + k * 2) = (n >> 6) ? pk2(v0.y, v1.y) : pk2(v0.x, v1.x);
        }
    }
    __syncthreads();
    { u32x4 ra[8], rb[8]; int mt = wave;
      if (mt < NCHP / 16) ssm_load_u(Ug, mt, fr, q, ra);
      while (mt < NCHP / 16) {
          const int m2 = mt + NWAVES; if (m2 < NCHP / 16) ssm_load_u(Ug, m2, fr, q, rb);
          ssm_s_tile(ra, g8, mt, fr, q, RS, TAB, Sg);
          mt = m2; if (mt >= NCHP / 16) break;
          const int m3 = mt + NWAVES; if (m3 < NCHP / 16) ssm_load_u(Ug, m3, fr, q, ra);
          ssm_s_tile(rb, g8, mt, fr, q, RS, TAB, Sg);
          mt = m3; } }
    asm volatile("s_waitcnt vmcnt(0)" ::: "memory");
    __syncthreads();
    {
        const f32x2 a16 = AP[16 * 64 + lane];
        const unsigned* Sl = Sg + (size_t)(wave * 64) * 64 + lane;
        unsigned sv[64];
#pragma unroll
        for (int i = 0; i < 64; ++i) sv[i] = __hip_atomic_load(Sl + (size_t)i * 64, RLX_AGENT);
        for (int e = tid; e < 256 * 64; e += NWAVES * 64) {
            const int n = e >> 6, p = e & 63, j = n >> 4, c = n & 15;
            const f32x2 z = cmul(CC[c * 64 + p], AP[(j + 1) * 64 + p]);
            *(LAS unsigned*)(TAB + n * ET_PITCH + p * 4) = pk2(z.x, -z.y);
        }
        f32x2 T = (f32x2){0.f, 0.f};
#pragma unroll
        for (int i = 0; i < 64; ++i) { T = cmul(a16, T); T.x += bf_lo(sv[i]); T.y += bf_hi(sv[i]); }
        XW[wave * 64 + lane] = T;
        __syncthreads();
        f32x2 a64 = a16;
#pragma unroll
        for (int i = 0; i < 6; ++i) a64 = cmul(a64, a64);
        f32x2 Hc = (f32x2){0.f, 0.f};
        for (int v = 0; v < wave; ++v) { Hc = cmul(a64, Hc); const f32x2 tv = XW[v * 64 + lane]; Hc.x += tv.x; Hc.y += tv.y; }
        unsigned* Hl = Hg + (size_t)(wave * 64) * 64 + lane;
#pragma unroll
        for (int i = 0; i < 64; ++i) { Hl[(size_t)i * 64] = cvt_pk_bf16(Hc.x, Hc.y); Hc = cmul(a16, Hc); Hc.x += bf_lo(sv[i]); Hc.y += bf_hi(sv[i]); }
        if (wave == NWAVES - 1) { args.out[O_SRP + (size_t)g * PST + lane] = Hc.x; args.out[O_SIP + (size_t)g * PST + lane] = Hc.y; }
        if (wave == 0) {
            f32x2 h0s[NB]; unsigned s0s[NB];
#pragma unroll
            for (int b = 0; b < NB; ++b) { const int c = SEQ / 16 + b;
                h0s[b] = (f32x2){args.in[3][((size_t)b * NGRP + g) * PST + lane], args.in[4][((size_t)b * NGRP + g) * PST + lane]};
                s0s[b] = __hip_atomic_load(Sg + (size_t)c * 64 + lane, RLX_AGENT); }
#pragma unroll
            for (int b = 0; b < NB; ++b) { const int c = SEQ / 16 + b;
                Hg[(size_t)c * 64 + lane] = cvt_pk_bf16(h0s[b].x, h0s[b].y);
                f32x2 ho = cmul(a16, h0s[b]); ho.x += bf_lo(s0s[b]); ho.y += bf_hi(s0s[b]);
                args.out[O_SRS + ((size_t)b * NGRP + g) * PST + lane] = ho.x; args.out[O_SIS + ((size_t)b * NGRP + g) * PST + lane] = ho.y; }
        }
    }
    asm volatile("s_waitcnt vmcnt(0)" ::: "memory");
    __syncthreads();
    { u32x4 ra[8], rb[8]; int mt = wave;
      if (mt < NCHP / 16) ssm_load_u(Ug, mt, fr, q, ra);
      while (mt < NCHP / 16) {
          const int m2 = mt + NWAVES; if (m2 < NCHP / 16) ssm_load_u(Ug, m2, fr, q, rb);
          ssm_y_tile(ra, g8, Hg, mt, fr, q, RS, KT, TAB, Yg);
          mt = m2; if (mt >= NCHP / 16) break;
          const int m3 = mt + NWAVES; if (m3 < NCHP / 16) ssm_load_u(Ug, m3, fr, q, ra);
          ssm_y_tile(rb, g8, Hg, mt, fr, q, RS, KT, TAB, Yg);
          mt = m3; } }
    __syncthreads();
}

template <int MODE>
__device__ __forceinline__ void fixup_rows(Frame& F, const Args& args, unsigned char* ws, const float* ss_in, float* ss_out, const bf16_t* Rin, bf16_t* Aout) {
    const bf16_t* slab = (const bf16_t*)(ws + WS_SLAB);
    LAS float* red = (LAS float*)F.lds;
    constexpr int NSPL = (MODE == 1 || MODE == 2) ? 4 : (MODE == 5 ? 8 : 16), LD = (MODE == 2) ? DFF : (MODE == 5 ? 2 * DM : DM);
    for (int r = F.vcu; r < NSAMP; r += F.G) {
        const int gr = SEQ + r, c0 = F.tid * 8;
        if constexpr (MODE == 2) {
            const float rstd = __builtin_amdgcn_rsqf(ss_in[gr] * (1.0f / DM) + EPS);
            bf16_t* HB = (bf16_t*)(ws + WS_H);
#pragma unroll 1
            for (int seg = 0; seg < 4; ++seg) { const int col = seg * DM + c0;
                f32x4 v0 = (f32x4){0.f, 0.f, 0.f, 0.f}, v1 = v0;
#pragma unroll
                for (int sp = 0; sp < NSPL; ++sp) { const u32x4 pw = *(const u32x4*)(slab + ((size_t)sp * NSAMP + r) * LD + col);
                    v0 += (f32x4){bf_lo(pw.x), bf_hi(pw.x), bf_lo(pw.y), bf_hi(pw.y)}; v1 += (f32x4){bf_lo(pw.z), bf_hi(pw.z), bf_lo(pw.w), bf_hi(pw.w)}; }
#pragma unroll
                for (int j = 0; j < 4; ++j) { const float p0 = fmaxf(v0[j] * rstd, 0.f), p1 = fmaxf(v1[j] * rstd, 0.f); v0[j] = p0 * p0; v1[j] = p1 * p1; }
                u32x4 w; w.x = cvt_pk_bf16(v0[0], v0[1]); w.y = cvt_pk_bf16(v0[2], v0[3]); w.z = cvt_pk_bf16(v1[0], v1[1]); w.w = cvt_pk_bf16(v1[2], v1[3]);
                *(u32x4*)((char*)HB + tiled_off(gr, col, DFF / 64)) = w; }
        } else {
            const int scol = (MODE == 5) ? ((c0 >> 7) * 256 + (c0 & 127)) : c0;
            f32x4 v0 = (f32x4){0.f, 0.f, 0.f, 0.f}, v1 = v0, b0 = v0, b1 = v0;
#pragma unroll
            for (int sp = 0; sp < NSPL; ++sp) { const bf16_t* p = slab + ((size_t)sp * NSAMP + r) * LD + scol; const u32x4 pw = *(const u32x4*)p;
                v0 += (f32x4){bf_lo(pw.x), bf_hi(pw.x), bf_lo(pw.y), bf_hi(pw.y)}; v1 += (f32x4){bf_lo(pw.z), bf_hi(pw.z), bf_lo(pw.w), bf_hi(pw.w)};
                if constexpr (MODE == 5) { const u32x4 qw = *(const u32x4*)(p + 128);
                    b0 += (f32x4){bf_lo(qw.x), bf_hi(qw.x), bf_lo(qw.y), bf_hi(qw.y)}; b1 += (f32x4){bf_lo(qw.z), bf_hi(qw.z), bf_lo(qw.w), bf_hi(qw.w)}; } }
            if constexpr (MODE == 1) { const float* xr = args.in[1] + (size_t)r * DM + c0; const float* sc = args.in[7] + c0;
                v0 = *(const f32x4*)xr + *(const f32x4*)sc * v0; v1 = *(const f32x4*)(xr + 4) + *(const f32x4*)(sc + 4) * v1; }
            else { const u32x4 rw = (MODE == 5) ? *(const u32x4*)(Rin + ((size_t)(c0 >> 4) * MROWS + gr) * 16 + (c0 & 15)) : *(const u32x4*)((const char*)Rin + tiled_off(gr, c0, DM / 64));
                if constexpr (MODE == 5) {
#pragma unroll
                    for (int j = 0; j < 4; ++j) { v0[j] *= sigmoidf_(b0[j]); v1[j] *= sigmoidf_(b1[j]); } }
                v0 += (f32x4){bf_lo(rw.x), bf_hi(rw.x), bf_lo(rw.y), bf_hi(rw.y)}; v1 += (f32x4){bf_lo(rw.z), bf_hi(rw.z), bf_lo(rw.w), bf_hi(rw.w)}; }
            float ss = (v0[0] * v0[0] + v0[1] * v0[1]) + (v0[2] * v0[2] + v0[3] * v0[3]) + (v1[0] * v1[0] + v1[1] * v1[1]) + (v1[2] * v1[2] + v1[3] * v1[3]);
            ss = wave_sum(ss); if (F.lane == 0) red[F.wave] = ss;
            __syncthreads();
            ss = ((red[0] + red[1]) + (red[2] + red[3])) + ((red[4] + red[5]) + (red[6] + red[7]));
            __syncthreads();
            if constexpr (MODE == 7) {
                const float rstd = 1.0f / sqrtf(ss * (1.0f / DM) + EPS); const float* gf = args.in[21] + c0; float* yo = args.out + O_YP + (size_t)gr * DM + c0;
                *(f32x4*)yo = v0 * rstd * *(const f32x4*)gf; *(f32x4*)(yo + 4) = v1 * rstd * *(const f32x4*)(gf + 4);
            } else {
                if (F.tid == 0) ss_out[gr] = ss;
                u32x4 w; w.x = cvt_pk_bf16(v0[0], v0[1]); w.y = cvt_pk_bf16(v0[2], v0[3]); w.z = cvt_pk_bf16(v1[0], v1[1]); w.w = cvt_pk_bf16(v1[2], v1[3]);
                if constexpr (MODE == 3) *(u32x4*)(Aout + ((size_t)(c0 >> 4) * MROWS + gr) * 16 + (c0 & 15)) = w;
                else *(u32x4*)((char*)Aout + tiled_off(gr, c0, DM / 64)) = w;
            }
        }
    }
}

__global__ void __launch_bounds__(NWAVES * 64, 2) trunk_fwd(Args args) {
    extern __shared__ __attribute__((aligned(16))) unsigned char lds[];
    Frame F;
    F.lds = (LAS unsigned char*)lds;
    F.tid = threadIdx.x; F.lane = F.tid & 63; F.wave = __builtin_amdgcn_readfirstlane(F.tid >> 6);
    F.G = gridDim.x; { const int bx = blockIdx.x; F.vcu = (F.G % 8 == 0) ? (bx % 8) * (F.G / 8) + bx / 8 : bx; }
    volatile LAS unsigned* MISC = (volatile LAS unsigned*)(F.lds + MISC_OFF);
    unsigned char* ws = args.ws;
    unsigned* ctl = (unsigned*)(ws + WS_CTL);
    for (int u = F.tid; u < 512 / 4; u += NWAVES * 64) ((LAS unsigned*)(F.lds + LDSCTL_OFF))[u] = 0u;
    __syncthreads();
    XcdBarrier bar; bar.bar = ctl + CW_BAR; bar.x = 0; bar.st = nullptr;
    if (N_LAUNCHES == 1) bar = xcd_barrier_post(ctl + CW_BAR, MISC + 8);
#define GRID_BAR() do { if (N_LAUNCHES == 1) xcd_barrier(bar); } while (0)
    const int lo = args.ph_lo, hi = args.ph_hi;
#define IN(k) (lo <= (k) && (k) < hi)
    bf16_t* WPOOL = (bf16_t*)(ws + WS_WPOOL); bf16_t* WGLU = (bf16_t*)(ws + WS_WGLU);
    bf16_t* WUP0 = (bf16_t*)(ws + WS_WUP0); bf16_t* WUP1 = (bf16_t*)(ws + WS_WUP1); bf16_t* WDN0 = (bf16_t*)(ws + WS_WDN0); bf16_t* WDN1 = (bf16_t*)(ws + WS_WDN1);
    bf16_t* A2 = (bf16_t*)(ws + WS_X); bf16_t* A0 = (bf16_t*)(ws + WS_A0); bf16_t* A1 = (bf16_t*)(ws + WS_A1); bf16_t* HB = (bf16_t*)(ws + WS_H);
    bf16_t* SLAB = (bf16_t*)(ws + WS_SLAB); float* SS1 = (float*)(ws + WS_SS); float* SS2 = SS1 + MROWS; float* SS3 = SS2 + MROWS; float* SS4 = SS3 + MROWS;

    if (IN(0)) {
        constexpr int T_POOL = 4 * 8 * 8, T_UP = 32 * 128, T_DN = 128 * 32, T_GLU = 32 * 32;
        constexpr int NT_ALL = T_POOL + 2 * T_UP + 2 * T_DN + 2 * T_GLU;
#define T0_DESC(it_, T) do { int r = (it_); \
            if (r < T_POOL) { const int gi = r >> 6, kb = (r >> 3) & 7, nb = r & 7; T = T0Tile{args.in[6] + (size_t)gi * 1024 * 1024, 1024, 1024, nullptr, WPOOL, gi * 1024 + nb * 128, kb * 128, nb * 128}; break; } r -= T_POOL; \
            if (r < 2 * T_UP) { const int l = r / T_UP, rr = r % T_UP, kb = rr >> 7, nb = rr & 127; T = T0Tile{args.in[19] + (size_t)l * DM * DFF, DM, DFF, args.in[18] + l * DM, l ? WUP1 : WUP0, nb * 128, kb * 128, nb * 128}; break; } r -= 2 * T_UP; \
            if (r < 2 * T_DN) { const int l = r / T_DN, rr = r % T_DN, kb = rr >> 5, nb = rr & 31; T = T0Tile{args.in[20] + (size_t)l * DFF * DM, DFF, DM, nullptr, l ? WDN1 : WDN0, nb * 128, kb * 128, nb * 128}; break; } r -= 2 * T_DN; \
            { const int ab = r / T_GLU, rr = r % T_GLU, kb = rr >> 5, nb = rr & 31; T = T0Tile{args.in[ab ? 17 : 16], DM, DM, nullptr, WGLU, nb * 256 + ab * 128, kb * 128, nb * 128}; } } while (0)
        {
            unsigned* qctr = ctl + CW_Q0; volatile LAS unsigned* qw = MISC + 40;
            constexpr unsigned QEND = (unsigned)(NCHUNK + NT_ALL);
            unsigned pend = 0u;
            if (F.tid == 0) pend = q_grab(qctr);
            unsigned a = q_next(F, qw, qctr, pend), b = q_next(F, qw, qctr, pend);
            while (a < (unsigned)NCHUNK) { t1_unit(F, args, (int)a, A0); a = b; b = q_next(F, qw, qctr, pend); }
            float va[16][2], vb[16][2]; T0Tile ta, tb;
            if (a < QEND) { T0_DESC((int)a - NCHUNK, ta); t0_load(F, ta, va); }
            while (a < QEND) {
                if (b < QEND) { T0_DESC((int)b - NCHUNK, tb); t0_load(F, tb, vb); }
                const unsigned c = t0_store(F, ta, va, qw, qctr, pend);
                if (b >= QEND) break;
                if (c < QEND) { T0_DESC((int)c - NCHUNK, ta); t0_load(F, ta, va); }
                const unsigned d = t0_store(F, tb, vb, qw, qctr, pend);
                a = c; b = d;
            }
        }
#undef T0_DESC
        if (IN(1)) GRID_BAR();
    }
    if (IN(1)) {
        pg8::Gemm g{(const char*)A0, (const char*)WPOOL, DM * 2u, 32u, 1024 * 2u, 16, 4, 64, 0u};
        pg8::Sched S; S.init(16, F.G, (int)blockIdx.x, 4);
        Epi<1> E{{args.in[0], args.in[1], nullptr, A1, nullptr, nullptr, args.in[7], nullptr, SS1, SLAB, DM}};
        pg8::gemm_phase(F.lds, g, S, E);
        if (IN(2)) GRID_BAR();
    }
    if (IN(2)) { fixup_rows<1>(F, args, ws, nullptr, SS1, nullptr, A1); if (IN(3)) GRID_BAR(); }
    if (IN(3)) {
        pg8::Gemm g{(const char*)A1, (const char*)WUP0, 0u, 8192u, DM * 2u, 64, 16, 0, (DM / 64) * 32768u};
        pg8::Sched S; S.init(64, F.G, (int)blockIdx.x, 4);
        Epi<2> E{{nullptr, nullptr, nullptr, nullptr, HB, nullptr, nullptr, SS1, nullptr, SLAB, DFF}};
        pg8::gemm_phase(F.lds, g, S, E);
#if REP_UP > 1
        __syncthreads();
        pg8::gemm_phase(F.lds, g, S, E);
#endif
        if (IN(4)) GRID_BAR();
    }
    if (IN(4)) { fixup_rows<2>(F, args, ws, SS1, nullptr, nullptr, nullptr); if (IN(5)) GRID_BAR(); }
    if (IN(5)) {
        pg8::Gemm g{(const char*)HB, (const char*)WDN0, 0u, 8192u, DFF * 2u, 256, 16, 0, (DFF / 64) * 32768u};
        pg8::Sched S; S.init(16, F.G, (int)blockIdx.x, 16);
        Epi<3> E{{nullptr, nullptr, A1, A0, nullptr, nullptr, nullptr, nullptr, SS2, SLAB, DM}};
        pg8::gemm_phase(F.lds, g, S, E);
        if (IN(6)) GRID_BAR();
    }
    if (IN(6)) { fixup_rows<3>(F, args, ws, nullptr, SS2, A1, A0); if (IN(7)) GRID_BAR(); }
    if (IN(7)) {
        for (int g = F.vcu; g < NGRP; g += F.G) ssm_group(F, args, g, A0, A1, SS2, (unsigned*)(ws + WS_SG), (unsigned*)(ws + WS_HG));
#if REP_SSM > 1
        for (int g = F.vcu; g < NGRP; g += F.G) ssm_group(F, args, g, A0, A1, SS2, (unsigned*)(ws + WS_SG), (unsigned*)(ws + WS_HG));
#endif
        if (IN(8)) GRID_BAR();
    }
    if (IN(8)) {
        pg8::Gemm g{(const char*)A1, (const char*)WGLU, 32u, (unsigned)MROWS * 32u, DM * 2u, 64, 8, 0, 0u};
        pg8::Sched S; S.init(32, F.G, (int)blockIdx.x, 8);
        Epi<4> E{{nullptr, nullptr, A0, A2, nullptr, nullptr, nullptr, nullptr, SS3, SLAB, 2 * DM}};
        pg8::gemm_phase(F.lds, g, S, E);
        if (IN(9)) GRID_BAR();
    }
    if (IN(9)) { fixup_rows<5>(F, args, ws, nullptr, SS3, A0, A2); if (IN(10)) GRID_BAR(); }
    if (IN(10)) {
        pg8::Gemm g{(const char*)A2, (const char*)WUP1, 0u, 8192u, DM * 2u, 64, 16, 0, (DM / 64) * 32768u};
        pg8::Sched S; S.init(64, F.G, (int)blockIdx.x, 4);
        Epi<2> E{{nullptr, nullptr, nullptr, nullptr, HB, nullptr, nullptr, SS3, nullptr, SLAB, DFF}};
        pg8::gemm_phase(F.lds, g, S, E);
        if (IN(11)) GRID_BAR();
    }
    if (IN(11)) { fixup_rows<2>(F, args, ws, SS3, nullptr, nullptr, nullptr); if (IN(12)) GRID_BAR(); }
    if (IN(12)) {
        pg8::Gemm g{(const char*)HB, (const char*)WDN1, 0u, 8192u, DFF * 2u, 256, 16, 0, (DFF / 64) * 32768u};
        pg8::Sched S; S.init(16, F.G, (int)blockIdx.x, 16);
        Epi<5> E{{nullptr, nullptr, A2, A1, nullptr, nullptr, nullptr, nullptr, SS4, SLAB, DM}};
        pg8::gemm_phase(F.lds, g, S, E);
        if (IN(13)) GRID_BAR();
    }
    if (IN(13)) {
        fixup_rows<7>(F, args, ws, nullptr, nullptr, A2, nullptr);
        const float* gf = args.in[21];
        const int gw = F.vcu * NWAVES + F.wave, NGW = F.G * NWAVES;
        for (int m = gw; m < SEQ; m += NGW) {
            float* row = args.out + O_YP + (size_t)m * DM + F.lane * 8; const bf16_t* xr = A1 + (size_t)m * DM + F.lane * 8;
            const float r = 1.0f / sqrtf(SS4[m] * (1.0f / DM) + EPS);
#pragma unroll 4
            for (int j = 0; j < 8; ++j) { const u32x4 w = *(const u32x4*)(xr + j * 512); const f32x4 g0 = *(const f32x4*)(gf + j * 512 + F.lane * 8), g1 = *(const f32x4*)(gf + j * 512 + F.lane * 8 + 4);
                *(f32x4*)(row + j * 512) = (f32x4){bf_lo(w.x), bf_hi(w.x), bf_lo(w.y), bf_hi(w.y)} * r * g0; *(f32x4*)(row + j * 512 + 4) = (f32x4){bf_lo(w.z), bf_hi(w.z), bf_lo(w.w), bf_hi(w.w)} * r * g1; }
        }
    }
#undef IN
#undef GRID_BAR
}

extern "C" void kernel_launch(void* const* d_in, const int* in_sizes, int n_in, void* d_out, int out_size, void* d_ws, size_t ws_size, hipStream_t stream) {
    static int grid = 0;
    if (grid == 0) {
        if (n_in != 22 || in_sizes[0] != SEQ * DM || (size_t)out_size != O_END || ws_size < WS_END) {
            fprintf(stderr, "kernel_launch: unexpected shapes (n_in %d, in0 %d, out %d, ws %zu); nothing launched\n", n_in, n_in > 0 ? in_sizes[0] : -1, out_size, ws_size); grid = -1; return; }
        int dev = 0, cus = 0, per_cu = 0;
        if (hipGetDevice(&dev) != hipSuccess || hipDeviceGetAttribute(&cus, hipDeviceAttributeMultiprocessorCount, dev) != hipSuccess) { fprintf(stderr, "kernel_launch: device query failed\n"); grid = -1; return; }
        if (hipFuncSetAttribute((const void*)trunk_fwd, hipFuncAttributeMaxDynamicSharedMemorySize, LDS_BYTES) != hipSuccess) { fprintf(stderr, "kernel_launch: hipFuncSetAttribute failed\n"); grid = -1; return; }
        if (hipOccupancyMaxActiveBlocksPerMultiprocessor(&per_cu, (const void*)trunk_fwd, NWAVES * 64, LDS_BYTES) != hipSuccess || per_cu < 1)
            fprintf(stderr, "kernel_launch: note: occupancy query reports %d workgroups per CU\n", per_cu);
        (void)hipGetLastError();
        grid = cus;
    }
    if (grid < 0) return;
    if (hipMemsetAsync((char*)d_ws + WS_CTL, 0, CTL_ZERO_BYTES, stream) != hipSuccess) { fprintf(stderr, "kernel_launch: memset failed\n"); return; }
    Args a{};
    for (int i = 0; i < 22; ++i) a.in[i] = (const float*)d_in[i];
    a.out = (float*)d_out; a.ws = (unsigned char*)d_ws;
    for (int li = 0; li < N_LAUNCHES; ++li) {
        a.ph_lo = (N_LAUNCHES == 1) ? 0 : li; a.ph_hi = (N_LAUNCHES == 1) ? NPHASE : li + 1;
        hipLaunchKernelGGL(trunk_fwd, dim3(grid), dim3(NWAVES * 64), LDS_BYTES, stream, a);
        const hipError_t le = hipPeekAtLastError();
        if (le != hipSuccess) { fprintf(stderr, "kernel_launch: launch %d failed: %s\n", li, hipGetErrorName(le)); break; }
    }
}
```

```cpp
#include <hip/hip_runtime.h>
#include <cstdio>
#include <cstdint>

#define LAS __attribute__((address_space(3)))
#define GAS __attribute__((address_space(1)))
typedef unsigned short bf16_t;
typedef short bf16x8 __attribute__((ext_vector_type(8)));
typedef float f32x4 __attribute__((ext_vector_type(4)));
typedef float f32x2 __attribute__((ext_vector_type(2)));
typedef unsigned u32x4 __attribute__((ext_vector_type(4)));
typedef unsigned u32x2 __attribute__((ext_vector_type(2)));

constexpr int DM = 4096, DFF = 16384, SEQ = 8192, NB = 8, LS = 16, NSAMP = NB * LS, MROWS = SEQ + NSAMP;
constexpr int NGRP = 256, PST = 64, CG = 16;
constexpr int NCHUNK = MROWS / 16;
constexpr int NCHP = 528;
constexpr float EPS = 1e-6f;
constexpr int NWAVES = 8;
#ifndef MK_N_LAUNCHES
#define MK_N_LAUNCHES 1
#endif
constexpr int NPHASE = 14;
#ifndef REP_CONV
#define REP_CONV 1
#endif
#ifndef REP_POOL
#define REP_POOL 1
#endif
#ifndef REP_SSM
#define REP_SSM 1
#endif
#ifndef REP_UP
#define REP_UP 1
#endif
constexpr int N_LAUNCHES = MK_N_LAUNCHES;

constexpr size_t O_YP = 0, O_YS = 33554432, O_PRP = 34078720, O_PRS = 34140160, O_SRP = 34631680, O_SIP = 34648064, O_SRS = 34664448, O_SIS = 34795520, O_END = 34926592;

constexpr size_t MiB = 1u << 20;
constexpr size_t WS_CTL = 0, CTL_ZERO_BYTES = 1 * MiB;
constexpr size_t WS_SS = 512 * 1024;
constexpr size_t WS_WPOOL = 2 * MiB, WS_WGLU = 10 * MiB, WS_WUP0 = 74 * MiB, WS_WUP1 = 202 * MiB, WS_WDN0 = 330 * MiB, WS_WDN1 = 458 * MiB;
constexpr size_t WS_X = 586 * MiB, WS_A0 = 716 * MiB, WS_A1 = 781 * MiB, WS_H = 847 * MiB, WS_SG = 1111 * MiB, WS_HG = 1177 * MiB, WS_SLAB = 1210 * MiB, WS_END = 1242 * MiB;
static_assert((size_t)MROWS * DM * 4 == 130 * MiB && (size_t)MROWS * DM * 2 == 65 * MiB && (size_t)MROWS * DFF * 2 == 260 * MiB, "buffer sizes");
static_assert((size_t)NGRP * NCHP * 128 * 4 == 66 * MiB && (size_t)NGRP * NCHP * 128 * 2 == 33 * MiB, "ssm scratch sizes");
constexpr int CW_Q0 = 128;
constexpr int CW_BAR = 4096;

constexpr int RING_BYTES = 131072, LDS_BYTES = 163840, LDSCTL_OFF = LDS_BYTES - 512, MISC_OFF = LDSCTL_OFF + 320;

__device__ __forceinline__ unsigned f2bf(float f) { unsigned u = __builtin_bit_cast(unsigned, f); return (u + 0x7fffu + ((u >> 16) & 1u)) >> 16; }
__device__ __forceinline__ unsigned pk2(float lo, float hi) { return f2bf(lo) | (f2bf(hi) << 16); }
__device__ __forceinline__ unsigned cvt_pk_bf16(float lo, float hi) { unsigned r; asm volatile("v_cvt_pk_bf16_f32 %0, %1, %2" : "=v"(r) : "v"(lo), "v"(hi)); return r; }
typedef __bf16 bf16x2_t __attribute__((ext_vector_type(2)));
__device__ __forceinline__ unsigned cvt_pk_bf16_c(float lo, float hi) { return __builtin_bit_cast(unsigned, __builtin_convertvector((f32x2){lo, hi}, bf16x2_t)); }
__device__ __forceinline__ float bf_lo(unsigned w) { return __builtin_bit_cast(float, w << 16); }
__device__ __forceinline__ float bf_hi(unsigned w) { return __builtin_bit_cast(float, w & 0xffff0000u); }

namespace pg8 {
constexpr int BM = 256, BK = 64, HALF = 128, HTB = HALF * BK * 2, STAGE_BYTES = 8 * HTB;
__host__ __device__ __forceinline__ int lds_byte(int r, int c) { const int st = (r >> 4) * 2 + (c >> 5), rr = r & 15, cc = c & 31, ob = rr * 64 + cc * 2; return st * 1024 + (ob ^ (((ob >> 9) & 1) << 5)); }
__host__ __device__ __forceinline__ void stage_rc(int b, int& R, int& C) { const int st = b / 1024, sb = b % 1024, swz = sb ^ (((sb >> 9) & 1) << 5); R = (st >> 1) * 16 + swz / 64; C = (st & 1) * 32 + (swz % 64) / 2; }
__host__ __device__ __forceinline__ int perm32(int rho) { const int n = rho >> 4, i = rho & 15; return 8 * (i >> 2) + 4 * n + (i & 3); }

struct Unit { int pm, pn, kind, ks; };
struct Gemm {
    const char* A; const char* Bt;
    unsigned a_rs, a_gs, b_rs;
    int nt_full, nt_split;
    int a_kgrp_pn4;
    unsigned a_ts;
};
struct Sched {
    int nN, G, c, nsplit, nwg;
    __device__ __forceinline__ void init(int nN_, int G_, int c_, int nsplit_) { nN = nN_; G = G_; c = c_; nsplit = nsplit_; nwg = 32 * nN_; }
    __device__ __forceinline__ bool next(int i, Unit& u) const {
        const long L = (long)i * G + c;
        const bool prompt = L < nwg;
        int wgid = prompt ? (int)L : 0; { const int q = nwg / 8, xcd = wgid % 8, off = wgid / 8; wgid = xcd * q + off; }
        const int nig = 8 * nN, gid = wgid / nig, fm = gid * 8;
        const int s = prompt ? 0 : (int)(L - nwg);
        const int pm_ = prompt ? fm + ((wgid % nig) % 8) : 32, pn_ = prompt ? (wgid % nig) / 8 : s / nsplit, kind_ = prompt ? 0 : 1, ks_ = prompt ? 0 : s % nsplit;
        u.pm = pm_; u.pn = pn_; u.kind = kind_; u.ks = ks_;
        return prompt || (L - nwg) < (long)nN * nsplit;
    }
};

template <class Epi>
__device__ __forceinline__ void gemm_phase(LAS unsigned char* lds, const Gemm g, const Sched& S, const Epi& E) {
    const int tid = threadIdx.x, wid = __builtin_amdgcn_readfirstlane(tid >> 6), lane = tid & 63, wr = wid >> 2, wc = wid & 3, fr = lane & 15, fq = lane >> 4;
    unsigned voffA[2], voffB[2];
#pragma unroll
    for (int i = 0; i < 2; ++i) { int R, C; stage_rc(tid * 16 + i * 8192, R, C); const int Rb = Epi::PERM ? ((R & ~31) + perm32(R & 31)) : R;
        voffA[i] = g.a_rs ? (unsigned)R * g.a_rs + (unsigned)(C >> 4) * g.a_gs + (unsigned)(C & 15) * 2u : (unsigned)(tid * 16 + i * 8192); voffB[i] = (unsigned)(tid * 16 + i * 8192); (void)Rb; }
    const size_t akstep = (size_t)g.a_gs * 4, bkstep = (size_t)(2 * HTB);
    const size_t ahstep = g.a_rs ? (size_t)HALF * g.a_rs : (size_t)HTB, bhstep = (size_t)HTB;
    const size_t atstep = g.a_rs ? 2 * ahstep : (size_t)g.a_ts, btstep = (size_t)256 * g.b_rs;
    const unsigned ldsw = (unsigned)wid * 1024u;
    const int aoff = lds_byte(wr * 64 + fr, fq * 8), boff = lds_byte(wc * 32 + fr, fq * 8);
#define PG8_SA(b, h) (((b) * 2 + (h)) * HTB)
#define PG8_SB(b, h) ((4 + (b) * 2 + (h)) * HTB)
#define PG8_STAGE(bufoff, gbase, voff) do { _Pragma("unroll") for (int _i = 0; _i < 2; ++_i) \
        __builtin_amdgcn_global_load_lds((const unsigned*)((const char*)(gbase) + (voff)[_i]), (LAS unsigned*)(lds + (bufoff) + ldsw + _i * 8192), 16, 0, 0); } while (0)
#define PG8_LDA(dst, b, h) do { _Pragma("unroll") for (int m = 0; m < 4; ++m) _Pragma("unroll") for (int k = 0; k < 2; ++k) dst[m][k] = *(const LAS bf16x8*)(lds + PG8_SA(b, h) + aoff + m * 2048 + k * 1024); } while (0)
#define PG8_LDB(dst, b, h) do { _Pragma("unroll") for (int n = 0; n < 2; ++n) _Pragma("unroll") for (int k = 0; k < 2; ++k) dst[n][k] = *(const LAS bf16x8*)(lds + PG8_SB(b, h) + boff + n * 2048 + k * 1024); } while (0)
#define PG8_MMA(ai, bj, At, Bt) do { __builtin_amdgcn_s_setprio(1); _Pragma("unroll") for (int m = 0; m < 4; ++m) _Pragma("unroll") for (int n = 0; n < 2; ++n) _Pragma("unroll") for (int k = 0; k < 2; ++k) \
        acc[ai][bj][m][n] = __builtin_amdgcn_mfma_f32_16x16x32_bf16(Bt[n][k], At[m][k], acc[ai][bj][m][n], 0, 0, 0); __builtin_amdgcn_s_setprio(0); } while (0)
#define PG8_WAIT_V(n) asm volatile("s_waitcnt vmcnt(" #n ")" ::: "memory")
#define PG8_WAIT_L(n) asm volatile("s_waitcnt lgkmcnt(" #n ")" ::: "memory")
#define PG8_BAR __builtin_amdgcn_s_barrier()
#define PG8_SCHED __builtin_amdgcn_sched_barrier(0)
#define PG8_UNIT_PTRS(u, pA, pB, hs, ntu) do { const int _nt = (u).kind ? g.nt_split : g.nt_full; \
        pA = g.A + (size_t)(u).pm * atstep + ((size_t)((u).pn >> 2) * g.a_kgrp_pn4 + (size_t)(u).ks * _nt * 4) * g.a_gs; \
        pB = g.Bt + (size_t)(u).pn * btstep + (size_t)(u).ks * _nt * bkstep; hs = (u).kind ? (size_t)0 : ahstep; ntu = _nt; } while (0)
    Unit cur, nxt; int ui = 0; bool st16 = false;
    if (!S.next(0, cur)) return;
    f32x4 acc[2][2][4][2];
#pragma unroll
    for (int a = 0; a < 2; ++a)
#pragma unroll
        for (int b = 0; b < 2; ++b)
#pragma unroll
            for (int m = 0; m < 4; ++m)
#pragma unroll
                for (int n = 0; n < 2; ++n) acc[a][b][m][n] = (f32x4){0.f, 0.f, 0.f, 0.f};
    bf16x8 At[4][2], B0[2][2], B1[2][2];
    const char* cA; const char* cB; size_t cH; int nt;
    PG8_UNIT_PTRS(cur, cA, cB, cH, nt);
    PG8_STAGE(PG8_SB(0, 0), cB, voffB); PG8_STAGE(PG8_SB(0, 1), cB + bhstep, voffB); PG8_STAGE(PG8_SA(0, 0), cA, voffA); PG8_STAGE(PG8_SA(0, 1), cA + cH, voffA);
    if (wr == 1) PG8_BAR;
    PG8_WAIT_V(2); PG8_BAR;
    PG8_STAGE(PG8_SB(1, 0), cB + bkstep, voffB); PG8_STAGE(PG8_SA(1, 0), cA + akstep, voffA); PG8_STAGE(PG8_SB(1, 1), cB + bhstep + bkstep, voffB);
    PG8_WAIT_V(6); PG8_BAR;
    for (;;) {
        const bool has_next = S.next(ui + 1, nxt);
        const char* nA = cA; const char* nB = cB; size_t nH = cH; int nnt = nt;
        if (has_next) PG8_UNIT_PTRS(nxt, nA, nB, nH, nnt);
#define PG8_ITER(FULL, W1, W2) { \
            const bool last = (t == nt - 2); \
            const char* a1 = cA + (size_t)(t + 1) * akstep; \
            const char* a2 = last ? nA : cA + (size_t)(t + 2) * akstep; const char* b2 = last ? nB : cB + (size_t)(t + 2) * bkstep; \
            const size_t h2 = last ? nH : cH; \
            const char* a3 = a2 + akstep; const char* b3 = b2 + bkstep; \
              \
            PG8_LDB(B0, 0, 0); PG8_LDB(B1, 0, 1); PG8_SCHED; PG8_LDA(At, 0, 0); PG8_STAGE(PG8_SA(1, 1), a1 + cH, voffA); \
            PG8_WAIT_V(W1); PG8_WAIT_L(0); PG8_BAR; PG8_MMA(0, 0, At, B0); PG8_MMA(0, 1, At, B1); PG8_BAR; PG8_SCHED; \
              \
            if (FULL) PG8_LDA(At, 0, 1); PG8_STAGE(PG8_SB(0, 0), b2, voffB); PG8_STAGE(PG8_SB(0, 1), b2 + bhstep, voffB); PG8_STAGE(PG8_SA(0, 0), a2, voffA); \
            PG8_WAIT_V(W2); PG8_WAIT_L(0); PG8_BAR; if (FULL) { PG8_MMA(1, 0, At, B0); PG8_MMA(1, 1, At, B1); } PG8_BAR; PG8_SCHED; \
              \
            PG8_LDB(B0, 1, 0); PG8_LDB(B1, 1, 1); PG8_SCHED; PG8_LDA(At, 1, 0); PG8_STAGE(PG8_SA(0, 1), a2 + h2, voffA); \
            PG8_WAIT_V(8); PG8_WAIT_L(0); PG8_BAR; PG8_MMA(0, 0, At, B0); PG8_MMA(0, 1, At, B1); PG8_BAR; PG8_SCHED; \
              \
            if (FULL) PG8_LDA(At, 1, 1); PG8_STAGE(PG8_SB(1, 0), b3, voffB); PG8_STAGE(PG8_SB(1, 1), b3 + bhstep, voffB); PG8_STAGE(PG8_SA(1, 0), a3, voffA); \
            PG8_WAIT_V(8); PG8_WAIT_L(0); PG8_BAR; if (FULL) { PG8_MMA(1, 0, At, B0); PG8_MMA(1, 1, At, B1); } PG8_BAR; PG8_SCHED; }
#define PG8_KLOOP(FULL) { for (int t = 0; t < nt; t += 2) PG8_ITER(FULL, 8, 8) }
        if (cur.kind == 0) PG8_KLOOP(true) else PG8_KLOOP(false)
#undef PG8_KLOOP
#undef PG8_ITER
        if (wr == 0) PG8_BAR;
        E(acc, cur, wr, wc, fr, fq);
        if (!has_next) break;
#pragma unroll
        for (int a = 0; a < 2; ++a)
#pragma unroll
            for (int b = 0; b < 2; ++b)
#pragma unroll
                for (int m = 0; m < 4; ++m)
#pragma unroll
                    for (int n = 0; n < 2; ++n) acc[a][b][m][n] = (f32x4){0.f, 0.f, 0.f, 0.f};
        st16 = Epi::ST16 || cur.kind != 0;
        cur = nxt; cA = nA; cB = nB; cH = nH; nt = nnt; ++ui;
        if (wr == 1) PG8_BAR;
    }
    PG8_WAIT_V(0);
    PG8_BAR;
#undef PG8_SA
#undef PG8_SB
#undef PG8_STAGE
#undef PG8_LDA
#undef PG8_LDB
#undef PG8_MMA
#undef PG8_WAIT_V
#undef PG8_WAIT_L
#undef PG8_BAR
#undef PG8_SCHED
#undef PG8_UNIT_PTRS
}
}

__device__ __forceinline__ size_t tiled_off(int row, int col, int nkt) { return (((size_t)(row >> 8) * nkt + (col >> 6)) * 2 + ((row >> 7) & 1)) * (size_t)pg8::HTB + pg8::lds_byte(row & 127, col & 63); }
struct EpiArgs {
    const float* xin_p; const float* xin_s; const bf16_t* Rin; bf16_t* Aout; bf16_t* H; float* outy; const float* vec; const float* ss_in; float* ss_out; bf16_t* slab; int slab_ld;
};
__device__ __forceinline__ float sigmoidf_(float x) { return __builtin_amdgcn_rcpf(1.0f + __expf(-x)); }
template <int MODE> struct Epi {
    static constexpr bool PERM = true, ST16 = (MODE == 2);
    EpiArgs a;
    __device__ __forceinline__ void operator()(const f32x4 (&acc)[2][2][4][2], const pg8::Unit& u, int wr, int wc, int fr, int fq) const {
        const int colb = u.pn * 256 + wc * 32 + 8 * fq;
        if (u.kind != 0) {
            bf16_t* sl = a.slab + (size_t)u.ks * NSAMP * a.slab_ld + colb;
#pragma unroll
            for (int m = 0; m < 4; ++m) { bf16_t* rp = sl + (size_t)(wr * 64 + m * 16 + fr) * a.slab_ld;
#pragma unroll
                for (int bj = 0; bj < 2; ++bj) { const f32x4 v0 = acc[0][bj][m][0], v1 = acc[0][bj][m][1];
                    u32x4 w; w.x = cvt_pk_bf16_c(v0[0], v0[1]); w.y = cvt_pk_bf16_c(v0[2], v0[3]); w.z = cvt_pk_bf16_c(v1[0], v1[1]); w.w = cvt_pk_bf16_c(v1[2], v1[3]);
                    *(u32x4*)(rp + 128 * bj) = w; } }
            return;
        }
#define SSQ8(v0, v1) ((v0[0] * v0[0] + v0[1] * v0[1]) + (v0[2] * v0[2] + v0[3] * v0[3]) + (v1[0] * v1[0] + v1[1] * v1[1]) + (v1[2] * v1[2] + v1[3] * v1[3]))
        float rs8[2][4];
        if constexpr (MODE == 2) {
#pragma unroll
            for (int ai = 0; ai < 2; ++ai)
#pragma unroll
                for (int m = 0; m < 4; ++m) rs8[ai][m] = a.ss_in[u.pm * 256 + ai * 128 + wr * 64 + fr + 16 * m]; }
#pragma unroll
        for (int ai = 0; ai < 2; ++ai) {
            const int gr0 = u.pm * 256 + ai * 128 + wr * 64 + fr;
            if constexpr (MODE == 2) {
#pragma unroll
                for (int m = 0; m < 4; ++m) { const float r = __builtin_amdgcn_rsqf(rs8[ai][m] * (1.0f / DM) + EPS);
#pragma unroll
                    for (int bj = 0; bj < 2; ++bj) { const int col = colb + 128 * bj;
                        f32x4 v0 = acc[ai][bj][m][0] * r, v1 = acc[ai][bj][m][1] * r;
#pragma unroll
                        for (int j = 0; j < 4; ++j) { const float p0 = fmaxf(v0[j], 0.f), p1 = fmaxf(v1[j], 0.f); v0[j] = p0 * p0; v1[j] = p1 * p1; }
                        u32x4 w; w.x = cvt_pk_bf16(v0[0], v0[1]); w.y = cvt_pk_bf16(v0[2], v0[3]); w.z = cvt_pk_bf16(v1[0], v1[1]); w.w = cvt_pk_bf16(v1[2], v1[3]);
                        *(u32x4*)((char*)a.H + tiled_off(gr0 + 16 * m, col, DFF / 64)) = w; } }
            } else {
                const int col4 = u.pn * 128 + wc * 32 + 8 * fq;
                f32x4 vs[2][2];
                if constexpr (MODE == 1) {
#pragma unroll
                    for (int bj = 0; bj < 2; ++bj) { vs[bj][0] = *(const f32x4*)(a.vec + colb + 128 * bj); vs[bj][1] = *(const f32x4*)(a.vec + colb + 128 * bj + 4); } }
                constexpr int NBJ = (MODE == 4) ? 1 : 2;
                constexpr int MB = (MODE == 1) ? 2 : 4;
#pragma unroll
                for (int mh = 0; mh < 4 / MB; ++mh) {
                    f32x4 xf[MODE == 1 ? MB : 1][2][2]; u32x4 xr4[MODE == 1 ? 1 : MB][NBJ];
#pragma unroll
                    for (int mm = 0; mm < MB; ++mm) { const int gr = gr0 + 16 * (MB * mh + mm);
#pragma unroll
                        for (int bj = 0; bj < NBJ; ++bj) {
                            if constexpr (MODE == 1) { const float* xr = ((gr < SEQ) ? a.xin_p + (size_t)gr * DM : a.xin_s + (size_t)(gr - SEQ) * DM) + colb + 128 * bj; xf[mm][bj][0] = *(const f32x4*)xr; xf[mm][bj][1] = *(const f32x4*)(xr + 4); }
                            else { const int col = (MODE == 4) ? col4 : colb + 128 * bj;
                                xr4[mm][bj] = (MODE == 4) ? *(const u32x4*)(a.Rin + ((size_t)(col >> 4) * MROWS + gr) * 16 + (col & 15)) : *(const u32x4*)((const char*)a.Rin + tiled_off(gr, col, DM / 64)); } } }
#pragma unroll
                    for (int mm = 0; mm < MB; ++mm) { const int m = MB * mh + mm, gr = gr0 + 16 * m; float ss = 0.f;
#pragma unroll
                        for (int bj = 0; bj < NBJ; ++bj) { const int col = (MODE == 4) ? col4 : colb + 128 * bj;
                            f32x4 v0, v1;
                            if constexpr (MODE == 1) { v0 = xf[mm][bj][0] + vs[bj][0] * acc[ai][bj][m][0]; v1 = xf[mm][bj][1] + vs[bj][1] * acc[ai][bj][m][1]; }
                            else { const u32x4 rw = xr4[mm][bj]; v0 = (f32x4){bf_lo(rw.x), bf_hi(rw.x), bf_lo(rw.y), bf_hi(rw.y)}; v1 = (f32x4){bf_lo(rw.z), bf_hi(rw.z), bf_lo(rw.w), bf_hi(rw.w)};
                                if constexpr (MODE == 4) {
#pragma unroll
                                    for (int j = 0; j < 4; ++j) { v0[j] += acc[ai][0][m][0][j] * sigmoidf_(acc[ai][1][m][0][j]); v1[j] += acc[ai][0][m][1][j] * sigmoidf_(acc[ai][1][m][1][j]); } }
                                else { v0 += acc[ai][bj][m][0]; v1 += acc[ai][bj][m][1]; } }
                            ss += SSQ8(v0, v1);
                            u32x4 w; w.x = cvt_pk_bf16(v0[0], v0[1]); w.y = cvt_pk_bf16(v0[2], v0[3]); w.z = cvt_pk_bf16(v1[0], v1[1]); w.w = cvt_pk_bf16(v1[2], v1[3]);
                            if constexpr (MODE == 3) *(u32x4*)(a.Aout + ((size_t)(col >> 4) * MROWS + gr) * 16 + (col & 15)) = w;
                            else if constexpr (MODE == 5) *(u32x4*)(a.Aout + (size_t)gr * DM + col) = w;
                            else *(u32x4*)((char*)a.Aout + tiled_off(gr, col, DM / 64)) = w;
                        }
                        ss += __shfl_xor(ss, 16); ss += __shfl_xor(ss, 32);
                        if (fq == 0) unsafeAtomicAdd(a.ss_out + gr, ss); }
                }
            }
        }
#undef SSQ8
    }
};

typedef GAS unsigned gu32;
#define RLX_AGENT __ATOMIC_RELAXED, __HIP_MEMORY_SCOPE_AGENT
#define XB_TMO      128
#define XB_XCNT(j)  (256  + 64 * (j))
#define XB_XSUB(j)  (1280 + 64 * (j))
#define XB_XGEN(j)  (2304 + 64 * (j))
#define XB_TOP      3328
#define XB_TOPGEN   3392
#define XCD_BAR_WORDS 3456
#define XB_SPIN_CAP (1u << 18)
__device__ __forceinline__ unsigned xb_ld(unsigned* p)              { return __hip_atomic_load(p, __ATOMIC_RELAXED, __HIP_MEMORY_SCOPE_AGENT); }
__device__ __forceinline__ unsigned xb_add(unsigned* p, unsigned v) { return __hip_atomic_fetch_add(p, v, __ATOMIC_RELAXED, __HIP_MEMORY_SCOPE_AGENT); }
__device__ __forceinline__ unsigned xb_xcc_id() { return (unsigned)__builtin_amdgcn_s_getreg((3 << 11) | 20) & 0xFu; }
#define XB_SPIN(cond, bar) do { unsigned _sp = 0; while (cond) { __builtin_amdgcn_s_sleep(1); \
    if ((++_sp & 255u) == 0u) { if (xb_ld(&(bar)[XB_TMO])) break; if (_sp > XB_SPIN_CAP) { atomicAdd(&(bar)[XB_TMO], 1u); break; } } } } while (0)
struct XcdBarrier { unsigned* bar; unsigned x; volatile LAS unsigned* st; };
__device__ __forceinline__ XcdBarrier xcd_barrier_post(unsigned* bar, volatile LAS unsigned* st) {
    XcdBarrier b; b.bar = bar; b.x = xb_xcc_id(); b.st = st;
    if (threadIdx.x == 0) (void)xb_add(&bar[XB_XCNT(b.x)], 1u);
    return b;
}
__device__ __forceinline__ void xcd_barrier_complete(unsigned* bar, unsigned x, unsigned& nloc, unsigned& nx) {
    const unsigned G = gridDim.x * gridDim.y * gridDim.z;
    unsigned sum, cnt, mine, sp = 0u;
    for (;;) {
        sum = 0u; cnt = 0u; mine = 0u;
#pragma unroll
        for (unsigned j = 0; j < 16; ++j) { const unsigned c = xb_ld(&bar[XB_XCNT(j)]); sum += c; cnt += (c > 0u) ? 1u : 0u; mine = (j == x) ? c : mine; }
        if (sum == G) break;
        __builtin_amdgcn_s_sleep(1);
        if ((++sp & 255u) == 0u) { if (xb_ld(&bar[XB_TMO])) break; if (sp > XB_SPIN_CAP) { atomicAdd(&bar[XB_TMO], 1u); break; } }
    }
    nloc = mine > 0u ? mine : 1u; nx = cnt > 0u ? cnt : 1u;
}
__device__ __forceinline__ void xcd_barrier(const XcdBarrier& b) {
    asm volatile("s_waitcnt vmcnt(0)" ::: "memory");
    __syncthreads();
    if (threadIdx.x == 0) {
        unsigned* bar = b.bar;
        __builtin_amdgcn_s_waitcnt(0);
        unsigned nloc = b.st[0], nx = b.st[1];
        if (nloc == 0u) { xcd_barrier_complete(bar, b.x, nloc, nx); b.st[0] = nloc; b.st[1] = nx; }
        const unsigned old = xb_add(&bar[XB_XSUB(b.x)], 1u);
        const unsigned gen = old / nloc;
        if (old + 1u == (gen + 1u) * nloc) {
            __builtin_amdgcn_fence(__ATOMIC_RELEASE, "agent");
            asm volatile("s_waitcnt vmcnt(0)" ::: "memory");
            const unsigned og = xb_add(&bar[XB_TOP], 1u);
            const unsigned tg = og / nx;
            if (og + 1u == (tg + 1u) * nx) xb_add(&bar[XB_TOPGEN], 1u);
            else XB_SPIN(xb_ld(&bar[XB_TOPGEN]) == tg, bar);
            __builtin_amdgcn_fence(__ATOMIC_ACQUIRE, "agent");
            xb_add(&bar[XB_XGEN(b.x)], 1u);
            asm volatile("s_waitcnt vmcnt(0)" ::: "memory");
        } else {
            XB_SPIN(xb_ld(&bar[XB_XGEN(b.x)]) == gen, bar);
            __builtin_amdgcn_fence(__ATOMIC_ACQUIRE, "agent");
            asm volatile("s_waitcnt vmcnt(0)" ::: "memory");
        }
    }
    __syncthreads();
}

struct Args { const float* in[22]; float* out; unsigned char* ws; int ph_lo, ph_hi; };
struct Frame {
    LAS unsigned char* lds; int tid, lane, wave, vcu, G;
};
__device__ __forceinline__ float wave_sum(float v) {
#pragma unroll
    for (int o = 1; o < 64; o <<= 1) v += __shfl_xor(v, o);
    return v;
}

__device__ __forceinline__ unsigned q_grab(unsigned* ctr) { return __hip_atomic_fetch_add(ctr, 1u, __ATOMIC_RELAXED, __HIP_MEMORY_SCOPE_AGENT); }
__device__ __forceinline__ unsigned q_next(Frame& F, volatile LAS unsigned* qw, unsigned* ctr, unsigned& pend) {
    if (F.tid == 0) { *qw = pend; pend = q_grab(ctr); }
    __syncthreads();
    const unsigned v = *qw;
    __syncthreads();
    return (unsigned)__builtin_amdgcn_readfirstlane((int)v);
}
constexpr int T0_PITCH = 264;
struct T0Tile { const float* W; int K, N; const float* gk; bf16_t* D; int drow0, k0, n0; };
__device__ __forceinline__ void t0_load(Frame& F, const T0Tile& t, float (&v)[16][2]) {
    const float* src = t.W + (size_t)(t.k0 + F.wave * 16) * t.N + t.n0 + F.lane;
#pragma unroll
    for (int i = 0; i < 16; ++i) { v[i][0] = src[(size_t)i * t.N]; v[i][1] = src[(size_t)i * t.N + 64]; }
}
__device__ __forceinline__ unsigned t0_store(Frame& F, const T0Tile& t, const float (&v)[16][2], volatile LAS unsigned* qw, unsigned* ctr, unsigned& pend) {
#pragma unroll
    for (int i = 0; i < 8; ++i) {
        const int kk = F.wave * 16 + 2 * i;
        const float g0 = t.gk ? t.gk[t.k0 + kk] : 1.f, g1 = t.gk ? t.gk[t.k0 + kk + 1] : 1.f;
#pragma unroll
        for (int j = 0; j < 2; ++j) *(LAS unsigned*)(F.lds + (F.lane + 64 * j) * T0_PITCH + kk * 2) = pk2(v[2 * i][j] * g0, v[2 * i + 1][j] * g1);
    }
    if (F.tid == 0) { *qw = pend; pend = q_grab(ctr); }
    __syncthreads();
    const unsigned nxt = *qw;
    const int n = F.tid >> 2, c = F.tid & 3;
#pragma unroll
    for (int i = 0; i < 4; ++i) {
        const int off = i * 64 + c * 16;
        const u32x2 lo = *(const LAS u32x2*)(F.lds + n * T0_PITCH + off), hi = *(const LAS u32x2*)(F.lds + n * T0_PITCH + off + 8);
        u32x4 w; w.x = lo.x; w.y = lo.y; w.z = hi.x; w.w = hi.y;
        const int gn = t.drow0 + n, rw = gn & 127, w5 = rw & 31, R = (rw & ~31) + 16 * ((w5 >> 2) & 1) + 4 * (w5 >> 3) + (w5 & 3), kk = t.k0 + (off >> 1);
        const size_t tile = ((size_t)(gn >> 8) * (t.K >> 6) + (kk >> 6)) * 2 + ((gn >> 7) & 1);
        *(u32x4*)((char*)t.D + tile * 16384 + pg8::lds_byte(R, kk & 63)) = w;
    }
    __syncthreads();
    return (unsigned)__builtin_amdgcn_readfirstlane((int)nxt);
}

__device__ __forceinline__ void t1_unit(Frame& F, const Args& args, int un, bf16_t* A0) {
    const float* xp = args.in[0]; const float* xs = args.in[1]; const float* cache = args.in[2]; const float* g0p = args.in[5];
    const bool samp = un >= SEQ / 16; const int b = un - SEQ / 16, t0 = samp ? 0 : un * 16;
    LAS float* rs = (LAS float*)(F.lds);
    for (int e = F.wave; e < 31; e += NWAVES) {
        const int t = t0 - 15 + e; float r = 0.f;
        if (t >= 0) { const float* xr = samp ? xs + ((size_t)b * LS + t) * DM : xp + (size_t)t * DM; float s = 0.f;
#pragma unroll 4
            for (int j = 0; j < 16; ++j) { const f32x4 q = *(const f32x4*)(xr + j * 256 + F.lane * 4); s += (q[0] * q[0] + q[1] * q[1]) + (q[2] * q[2] + q[3] * q[3]); }
            r = 1.0f / sqrtf(wave_sum(s) * (1.0f / DM) + EPS); }
        if (F.lane == 0) rs[e] = r;
    }
    __syncthreads();
    const int ch0 = F.tid * 8, w = 2 << (F.tid >> 7);
    const f32x4 ga = *(const f32x4*)(g0p + ch0), gb = *(const f32x4*)(g0p + ch0 + 4);
#define T1_FETCH(e, o0, o1) do { const int _t = t0 - 15 + (e); \
        if (_t >= 0) { const float* _xr = (samp ? xs + ((size_t)b * LS + _t) * DM : xp + (size_t)_t * DM) + ch0; const float _r = rs[(e)]; \
            o0 = *(const f32x4*)_xr * _r * ga; o1 = *(const f32x4*)(_xr + 4) * _r * gb; } \
        else if (samp) { const float* _hr = cache + ((size_t)b * 15 + (e)) * DM + ch0; o0 = *(const f32x4*)_hr; o1 = *(const f32x4*)(_hr + 4); } \
        else { o0 = (f32x4){0.f, 0.f, 0.f, 0.f}; o1 = o0; } } while (0)
    f32x4 s0 = (f32x4){0.f, 0.f, 0.f, 0.f}, s1 = s0;
    for (int e = 16 - w; e < 15; ++e) { f32x4 q0, q1; T1_FETCH(e, q0, q1); s0 += q0; s1 += q1; }
    for (int r = 0; r < 16; ++r) {
        const int e = 15 + r, t = t0 + r; f32x4 c0, c1; T1_FETCH(e, c0, c1); s0 += c0; s1 += c1;
        const float inv = 1.0f / (float)(samp ? w : (t + 1 < w ? t + 1 : w));
        const f32x4 p0 = s0 * inv - c0, p1 = s1 * inv - c1;
        const size_t gr = samp ? (size_t)SEQ + b * LS + t : (size_t)t;
        u32x4 o; o.x = pk2(p0[0], p0[1]); o.y = pk2(p0[2], p0[3]); o.z = pk2(p1[0], p1[1]); o.w = pk2(p1[2], p1[3]);
        *(u32x4*)(A0 + gr * DM + ch0) = o;
        if (samp) { if (r >= 1) { float* po = args.out + O_PRS + ((size_t)b * 15 + (r - 1)) * DM + ch0; *(f32x4*)po = c0; *(f32x4*)(po + 4) = c1; } }
        else if (t >= SEQ - 15) { float* po = args.out + O_PRP + (size_t)(t - (SEQ - 15)) * DM + ch0; *(f32x4*)po = c0; *(f32x4*)(po + 4) = c1; }
        f32x4 q0, q1; T1_FETCH(e - w + 1, q0, q1); s0 -= q0; s1 -= q1;
    }
#undef T1_FETCH
    __syncthreads();
}

constexpr int L_AP = 0, L_APT = 8704, L_BB = 17408, L_CC = 25600, L_CCT = 33792, L_KT = 41984, L_DD = 50176, L_XW = 50432, L_RS = 54528, L_TAB = 87808;
constexpr int FT_PITCH = 528, ET_PITCH = 272;
static_assert(L_TAB + 256 * ET_PITCH <= LDSCTL_OFF && L_TAB + 128 * FT_PITCH <= LDSCTL_OFF, "SSM LDS map");
__device__ __forceinline__ f32x2 cmul(f32x2 a, f32x2 b) { return (f32x2){a.x * b.x - a.y * b.y, a.x * b.y + a.y * b.x}; }
__device__ __forceinline__ float gelu_tanh(float x) {
    const float z = 0.7978845608028654f * (x + 0.044715f * x * x * x);
    const float e = __expf(2.0f * z);
    const float th = 1.0f - 2.0f * __builtin_amdgcn_rcpf(1.0f + e);
    return 0.5f * x * (1.0f + th);
}
__device__ __forceinline__ void ssm_load_u(const bf16_t* Ug, int mt, int fr, int q, u32x4 (&raw)[8]) {
    const int chunk = mt * 16 + fr; const bool valid = chunk < NCHUNK;
#pragma unroll
    for (int ks = 0; ks < 8; ++ks) raw[ks] = valid ? *(const u32x4*)(Ug + ((size_t)chunk * 16 + 2 * ks + (q >> 1)) * 16 + (q & 1) * 8) : (u32x4){0u, 0u, 0u, 0u};
}
__device__ __forceinline__ void ssm_load_h(const unsigned* Hg, int mt, int fr, int q, u32x4 (&hw)[4]) {
    const int chunk = mt * 16 + fr; const bool valid = chunk < NCHUNK;
#pragma unroll
    for (int kh = 0; kh < 4; ++kh) hw[kh] = valid ? *(const u32x4*)(Hg + (size_t)chunk * 64 + kh * 16 + q * 4) : (u32x4){0u, 0u, 0u, 0u};
}
__device__ __forceinline__ bf16x8 ssm_scale(const u32x4 raw, float r, const float (&g8)[8]) {
    u32x4 w; w.x = cvt_pk_bf16_c(bf_lo(raw.x) * (r * g8[0]), bf_hi(raw.x) * (r * g8[1])); w.y = cvt_pk_bf16_c(bf_lo(raw.y) * (r * g8[2]), bf_hi(raw.y) * (r * g8[3]));
    w.z = cvt_pk_bf16_c(bf_lo(raw.z) * (r * g8[4]), bf_hi(raw.z) * (r * g8[5])); w.w = cvt_pk_bf16_c(bf_lo(raw.w) * (r * g8[6]), bf_hi(raw.w) * (r * g8[7]));
    return __builtin_bit_cast(bf16x8, w);
}
__device__ __forceinline__ void ssm_s_tile(const u32x4 (&raw)[8], const float (&g8)[8], int mt, int fr, int q, const LAS float* RS, const LAS unsigned char* TAB, unsigned* Sg) {
    const int chunk = mt * 16 + fr; const bool valid = chunk < NCHUNK;
    f32x4 acc[8];
#pragma unroll
    for (int i = 0; i < 8; ++i) acc[i] = (f32x4){0.f, 0.f, 0.f, 0.f};
#pragma unroll
    for (int ks = 0; ks < 8; ++ks) {
        const bf16x8 af = ssm_scale(raw[ks], valid ? RS[chunk * 16 + 2 * ks + (q >> 1)] : 0.f, g8);
#pragma unroll
        for (int nt = 0; nt < 8; ++nt) { const bf16x8 bfr = *(const LAS bf16x8*)(TAB + (nt * 16 + fr) * FT_PITCH + (ks * 32 + q * 8) * 2);
            acc[nt] = __builtin_amdgcn_mfma_f32_16x16x32_bf16(bfr, af, acc[nt], 0, 0, 0); }
    }
    asm volatile("s_nop 7\n\ts_nop 7" : "+v"(acc[0]), "+v"(acc[1]), "+v"(acc[2]), "+v"(acc[3]), "+v"(acc[4]), "+v"(acc[5]), "+v"(acc[6]), "+v"(acc[7]));
#pragma unroll
    for (int nt = 0; nt < 4; ++nt) { u32x4 w;
        w.x = cvt_pk_bf16(acc[nt][0], acc[nt + 4][0]); w.y = cvt_pk_bf16(acc[nt][1], acc[nt + 4][1]); w.z = cvt_pk_bf16(acc[nt][2], acc[nt + 4][2]); w.w = cvt_pk_bf16(acc[nt][3], acc[nt + 4][3]);
        *(u32x4*)(Sg + (size_t)chunk * 64 + nt * 16 + q * 4) = w; }
}
__device__ __forceinline__ void ssm_y_tile(const u32x4 (&raw)[8], const float (&g8)[8], const unsigned* Hg, int mt, int fr, int q, const LAS float* RS, const LAS bf16_t* KT, const LAS unsigned char* ET, bf16_t* Yg) {
    const int chunk = mt * 16 + fr; const bool valid = chunk < NCHUNK;
    u32x4 hw[4]; ssm_load_h(Hg, mt, fr, q, hw);
    f32x4 acc[16];
#pragma unroll
    for (int i = 0; i < 16; ++i) acc[i] = (f32x4){0.f, 0.f, 0.f, 0.f};
#pragma unroll
    for (int ks = 0; ks < 8; ++ks) {
        const int s = 2 * ks + (q >> 1), c0 = (q & 1) * 8;
        const bf16x8 af = ssm_scale(raw[ks], valid ? RS[chunk * 16 + s] : 0.f, g8);
#pragma unroll
        for (int j = 2 * ks; j < 16; ++j) {
            const int d = j - s;
            u32x4 bw = *(const LAS u32x4*)(KT + ((d < 0 ? 0 : d) * 256 + fr * 16 + c0));
            if (d < 0) bw = (u32x4){0u, 0u, 0u, 0u};
            acc[j] = __builtin_amdgcn_mfma_f32_16x16x32_bf16(__builtin_bit_cast(bf16x8, bw), af, acc[j], 0, 0, 0);
            if ((j & 3) == 3) __builtin_amdgcn_sched_barrier(0);
        }
    }
#pragma unroll
    for (int kh = 0; kh < 4; ++kh) {
        const bf16x8 af = __builtin_bit_cast(bf16x8, hw[kh]);
#pragma unroll
        for (int j = 0; j < 16; ++j) { const bf16x8 bfr = *(const LAS bf16x8*)(ET + (j * 16 + fr) * ET_PITCH + (kh * 32 + q * 8) * 2);
            acc[j] = __builtin_amdgcn_mfma_f32_16x16x32_bf16(bfr, af, acc[j], 0, 0, 0);
            if ((j & 3) == 3) __builtin_amdgcn_sched_barrier(0); }
    }
    if (valid) {
#pragma unroll
        for (int j = 0; j < 16; ++j) { u32x2 o; o.x = cvt_pk_bf16(gelu_tanh(acc[j][0]), gelu_tanh(acc[j][1])); o.y = cvt_pk_bf16(gelu_tanh(acc[j][2]), gelu_tanh(acc[j][3]));
            *(u32x2*)(Yg + ((size_t)chunk * 16 + j) * 16 + q * 4) = o; }
    }
}
__device__ __forceinline__ void ssm_group(Frame& F, const Args& args, int g, const bf16_t* UgAll, bf16_t* YgAll, const float* ss, unsigned* SgAll, unsigned* HgAll) {
    LAS f32x2* AP = (LAS f32x2*)(F.lds + L_AP);
    LAS f32x2* APT = (LAS f32x2*)(F.lds + L_APT);
    LAS f32x2* BB = (LAS f32x2*)(F.lds + L_BB);
    LAS f32x2* CC = (LAS f32x2*)(F.lds + L_CC);
    LAS f32x2* CCT = (LAS f32x2*)(F.lds + L_CCT);
    LAS bf16_t* KT = (LAS bf16_t*)(F.lds + L_KT);
    LAS float* DD = (LAS float*)(F.lds + L_DD);
    LAS f32x2* XW = (LAS f32x2*)(F.lds + L_XW);
    LAS float* RS = (LAS float*)(F.lds + L_RS);
    LAS unsigned char* TAB = F.lds + L_TAB;
    const bf16_t* Ug = UgAll + (size_t)g * MROWS * 16; bf16_t* Yg = YgAll + (size_t)g * MROWS * 16;
    unsigned* Sg = SgAll + (size_t)g * NCHP * 64; unsigned* Hg = HgAll + (size_t)g * NCHP * 64;
    const int tid = F.tid, lane = F.lane, wave = F.wave, fr = lane & 15, q = lane >> 4;
    float g8[8];
#pragma unroll
    for (int i = 0; i < 8; ++i) g8[i] = args.in[5][DM + g * CG + (q & 1) * 8 + i];
    {
        const float dt = expf(args.in[10][g]);
        for (int e = tid; e < 17 * PST; e += NWAVES * 64) { const int tau = e >> 6, p = e & 63;
            const float are = args.in[8][g * PST + p], aim = args.in[9][g * PST + p];
            double ang = (double)aim * (double)dt * (double)tau; ang -= 6.283185307179586 * floor(ang * 0.15915494309189535);
            float sn, cs; sincosf((float)ang, &sn, &cs); const float mag = expf(are * dt * (float)tau);
            const f32x2 v = (f32x2){mag * cs, mag * sn}; AP[e] = v; APT[p * 17 + tau] = v; }
        if (tid < PST) { const int p = tid;
            const float are = args.in[8][g * PST + p], aim = args.in[9][g * PST + p]; const f32x2 z = (f32x2){are * dt, aim * dt}; f32x2 qv;
            if (z.x * z.x + z.y * z.y < 0.0625f) { f32x2 h = (f32x2){1.f, 0.f};
#pragma unroll
                for (int k = 8; k >= 2; --k) { h = cmul(z, h); h.x = 1.f + h.x * (1.0f / k); h.y = h.y * (1.0f / k); }
                qv = (f32x2){dt * h.x, dt * h.y};
            } else { float sn, cs; sincosf(z.y, &sn, &cs); const float mag = expf(z.x); const float nr = mag * cs - 1.0f, ni = mag * sn, den = 1.0f / (are * are + aim * aim);
                qv = (f32x2){(nr * are + ni * aim) * den, (ni * are - nr * aim) * den}; }
            XW[p] = qv; }
        for (int e = tid; e < CG * PST; e += NWAVES * 64) { const f32x2 v = (f32x2){args.in[13][(size_t)g * CG * PST + e], args.in[14][(size_t)g * CG * PST + e]}; CC[e] = v; CCT[(e & 63) * 16 + (e >> 6)] = v; }
        if (tid < CG) DD[tid] = args.in[15][g * CG + tid];
        for (int e = tid; e < MROWS; e += NWAVES * 64) RS[e] = __builtin_amdgcn_rsqf(ss[e] * (1.0f / DM) + EPS);
        __syncthreads();
        for (int e = tid; e < PST * CG; e += NWAVES * 64) { const int p = e >> 4;
            BB[e] = cmul(XW[p], (f32x2){args.in[11][(size_t)g * PST * CG + e], args.in[12][(size_t)g * PST * CG + e]}); }
    }
    __syncthreads();
    {
        const int tau = tid >> 5, c = (tid >> 1) & 15, c0 = (tid & 1) * 8; float k8[8];
#pragma unroll
        for (int i = 0; i < 8; ++i) k8[i] = (tau == 0 && c == c0 + i) ? DD[c] : 0.f;
        for (int p = 0; p < PST; ++p) { const f32x2 m = cmul(CCT[p * 16 + c], AP[tau * 64 + p]);
#pragma unroll
            for (int i = 0; i < 8; ++i) { const f32x2 bb = BB[p * 16 + c0 + i]; k8[i] += m.x * bb.x - m.y * bb.y; } }
        u32x4 w; w.x = pk2(k8[0], k8[1]); w.y = pk2(k8[2], k8[3]); w.z = pk2(k8[4], k8[5]); w.w = pk2(k8[6], k8[7]);
        *(LAS u32x4*)(KT + (tau * 256 + c * 16 + c0)) = w;
        for (int e = tid; e < 128 * 128; e += NWAVES * 64) {
            const int n = e >> 7, k = (e & 127) * 2, p = n & 63, s = k >> 4, cp = k & 15;
            const f32x2 ap = APT[p * 17 + 15 - s], v0 = cmul(ap, BB[p * 16 + cp]), v1 = cmul(ap, BB[p * 16 + cp + 1]);
            *(LAS unsigned*)(TAB + n * FT_PITCH + k * 2) = (n >> 6) ? pk2(v0.y, v1.y) : pk2(v0.x, v1.x);
        }
    }
    __syncthreads();
    { u32x4 ra[8], rb[8]; int mt = wave;
      if (mt < NCHP / 16) ssm_load_u(Ug, mt, fr, q, ra);
      while (mt < NCHP / 16) {
          const int m2 = mt + NWAVES; if (m2 < NCHP / 16) ssm_load_u(Ug, m2, fr, q, rb);
          ssm_s_tile(ra, g8, mt, fr, q, RS, TAB, Sg);
          mt = m2; if (mt >= NCHP / 16) break;
          const int m3 = mt + NWAVES; if (m3 < NCHP / 16) ssm_load_u(Ug, m3, fr, q, ra);
          ssm_s_tile(rb, g8, mt, fr, q, RS, TAB, Sg);
          mt = m3; } }
    asm volatile("s_waitcnt vmcnt(0)" ::: "memory");
    __syncthreads();
    {
        const f32x2 a16 = AP[16 * 64 + lane];
        const unsigned* Sl = Sg + (size_t)(wave * 64) * 64 + lane;
        unsigned sv[64];
#pragma unroll
        for (int i = 0; i < 64; ++i) sv[i] = __hip_atomic_load(Sl + (size_t)i * 64, RLX_AGENT);
        for (int e = tid; e < 256 * 64; e += NWAVES * 64) {
            const int n = e >> 6, p = e & 63, j = n >> 4, c = n & 15;
            const f32x2 z = cmul(CC[c * 64 + p], AP[(j + 1) * 64 + p]);
            *(LAS unsigned*)(TAB + n * ET_PITCH + p * 4) = pk2(z.x, -z.y);
        }
        f32x2 T = (f32x2){0.f, 0.f};
#pragma unroll
        for (int i = 0; i < 64; ++i) { T = cmul(a16, T); T.x += bf_lo(sv[i]); T.y += bf_hi(sv[i]); }
        XW[wave * 64 + lane] = T;
        __syncthreads();
        f32x2 a64 = a16;
#pragma unroll
        for (int i = 0; i < 6; ++i) a64 = cmul(a64, a64);
        f32x2 Hc = (f32x2){0.f, 0.f};
        for (int v = 0; v < wave; ++v) { Hc = cmul(a64, Hc); const f32x2 tv = XW[v * 64 + lane]; Hc.x += tv.x; Hc.y += tv.y; }
        unsigned* Hl = Hg + (size_t)(wave * 64) * 64 + lane;
#pragma unroll
        for (int i = 0; i < 64; ++i) { Hl[(size_t)i * 64] = cvt_pk_bf16(Hc.x, Hc.y); Hc = cmul(a16, Hc); Hc.x += bf_lo(sv[i]); Hc.y += bf_hi(sv[i]); }
        if (wave == NWAVES - 1) { args.out[O_SRP + (size_t)g * PST + lane] = Hc.x; args.out[O_SIP + (size_t)g * PST + lane] = Hc.y; }
        if (wave == 0) {
            f32x2 h0s[NB]; unsigned s0s[NB];
#pragma unroll
            for (int b = 0; b < NB; ++b) { const int c = SEQ / 16 + b;
                h0s[b] = (f32x2){args.in[3][((size_t)b * NGRP + g) * PST + lane], args.in[4][((size_t)b * NGRP + g) * PST + lane]};
                s0s[b] = __hip_atomic_load(Sg + (size_t)c * 64 + lane, RLX_AGENT); }
#pragma unroll
            for (int b = 0; b < NB; ++b) { const int c = SEQ / 16 + b;
                Hg[(size_t)c * 64 + lane] = cvt_pk_bf16(h0s[b].x, h0s[b].y);
                f32x2 ho = cmul(a16, h0s[b]); ho.x += bf_lo(s0s[b]); ho.y += bf_hi(s0s[b]);
                args.out[O_SRS + ((size_t)b * NGRP + g) * PST + lane] = ho.x; args.out[O_SIS + ((size_t)b * NGRP + g) * PST + lane] = ho.y; }
        }
    }
    asm volatile("s_waitcnt vmcnt(0)" ::: "memory");
    __syncthreads();
    { u32x4 ra[8], rb[8]; int mt = wave;
      if (mt < NCHP / 16) ssm_load_u(Ug, mt, fr, q, ra);
      while (mt < NCHP / 16) {
          const int m2 = mt + NWAVES; if (m2 < NCHP / 16) ssm_load_u(Ug, m2, fr, q, rb);
          ssm_y_tile(ra, g8, Hg, mt, fr, q, RS, KT, TAB, Yg);
          mt = m2; if (mt >= NCHP / 16) break;
          const int m3 = mt + NWAVES; if (m3 < NCHP / 16) ssm_load_u(Ug, m3, fr, q, ra);
          ssm_y_tile(rb, g8, Hg, mt, fr, q, RS, KT, TAB, Yg);
          mt = m3; } }
    __syncthreads();
}

template <int MODE>
__device__ __forceinline__ void fixup_rows(Frame& F, const Args& args, unsigned char* ws, const float* ss_in, float* ss_out, const bf16_t* Rin, bf16_t* Aout) {
    const bf16_t* slab = (const bf16_t*)(ws + WS_SLAB);
    LAS float* red = (LAS float*)F.lds;
    constexpr int NSPL = (MODE == 1 || MODE == 2) ? 4 : (MODE == 5 ? 8 : 16), LD = (MODE == 2) ? DFF : (MODE == 5 ? 2 * DM : DM);
    if constexpr (MODE == 2) {
        const float* ssp = ss_in; bf16_t* HB = (bf16_t*)(ws + WS_H);
        for (int it = F.vcu; it < 2 * NSAMP; it += F.G) { const int r = it % NSAMP, sh = it / NSAMP, gr = SEQ + r, c0 = F.tid * 8;
            const float rstd = __builtin_amdgcn_rsqf(ssp[gr] * (1.0f / DM) + EPS);
            u32x4 pw[2][NSPL];
#pragma unroll
            for (int s2 = 0; s2 < 2; ++s2)
#pragma unroll
                for (int sp = 0; sp < NSPL; ++sp) pw[s2][sp] = *(const u32x4*)(slab + ((size_t)sp * NSAMP + r) * LD + (sh * 2 + s2) * DM + c0);
#pragma unroll
            for (int s2 = 0; s2 < 2; ++s2) { const int col = (sh * 2 + s2) * DM + c0;
                f32x4 v0 = (f32x4){0.f, 0.f, 0.f, 0.f}, v1 = v0;
#pragma unroll
                for (int sp = 0; sp < NSPL; ++sp) { const u32x4 q = pw[s2][sp];
                    v0 += (f32x4){bf_lo(q.x), bf_hi(q.x), bf_lo(q.y), bf_hi(q.y)}; v1 += (f32x4){bf_lo(q.z), bf_hi(q.z), bf_lo(q.w), bf_hi(q.w)}; }
#pragma unroll
                for (int j = 0; j < 4; ++j) { const float p0 = fmaxf(v0[j] * rstd, 0.f), p1 = fmaxf(v1[j] * rstd, 0.f); v0[j] = p0 * p0; v1[j] = p1 * p1; }
                u32x4 w; w.x = cvt_pk_bf16(v0[0], v0[1]); w.y = cvt_pk_bf16(v0[2], v0[3]); w.z = cvt_pk_bf16(v1[0], v1[1]); w.w = cvt_pk_bf16(v1[2], v1[3]);
                *(u32x4*)((char*)HB + tiled_off(gr, col, DFF / 64)) = w; }
        }
        return;
    }
    for (int r = F.vcu; r < NSAMP; r += F.G) {
        const int gr = SEQ + r, c0 = F.tid * 8;
        if constexpr (MODE == 2) {
        } else {
            const int scol = (MODE == 5) ? ((c0 >> 7) * 256 + (c0 & 127)) : c0;
            f32x4 v0 = (f32x4){0.f, 0.f, 0.f, 0.f}, v1 = v0, b0 = v0, b1 = v0;
#pragma unroll
            for (int sp = 0; sp < NSPL; ++sp) { const bf16_t* p = slab + ((size_t)sp * NSAMP + r) * LD + scol; const u32x4 pw = *(const u32x4*)p;
                v0 += (f32x4){bf_lo(pw.x), bf_hi(pw.x), bf_lo(pw.y), bf_hi(pw.y)}; v1 += (f32x4){bf_lo(pw.z), bf_hi(pw.z), bf_lo(pw.w), bf_hi(pw.w)};
                if constexpr (MODE == 5) { const u32x4 qw = *(const u32x4*)(p + 128);
                    b0 += (f32x4){bf_lo(qw.x), bf_hi(qw.x), bf_lo(qw.y), bf_hi(qw.y)}; b1 += (f32x4){bf_lo(qw.z), bf_hi(qw.z), bf_lo(qw.w), bf_hi(qw.w)}; } }
            if constexpr (MODE == 1) { const float* xr = args.in[1] + (size_t)r * DM + c0; const float* sc = args.in[7] + c0;
                v0 = *(const f32x4*)xr + *(const f32x4*)sc * v0; v1 = *(const f32x4*)(xr + 4) + *(const f32x4*)(sc + 4) * v1; }
            else { const u32x4 rw = (MODE == 5) ? *(const u32x4*)(Rin + ((size_t)(c0 >> 4) * MROWS + gr) * 16 + (c0 & 15)) : *(const u32x4*)((const char*)Rin + tiled_off(gr, c0, DM / 64));
                if constexpr (MODE == 5) {
#pragma unroll
                    for (int j = 0; j < 4; ++j) { v0[j] *= sigmoidf_(b0[j]); v1[j] *= sigmoidf_(b1[j]); } }
                v0 += (f32x4){bf_lo(rw.x), bf_hi(rw.x), bf_lo(rw.y), bf_hi(rw.y)}; v1 += (f32x4){bf_lo(rw.z), bf_hi(rw.z), bf_lo(rw.w), bf_hi(rw.w)}; }
            float ss = (v0[0] * v0[0] + v0[1] * v0[1]) + (v0[2] * v0[2] + v0[3] * v0[3]) + (v1[0] * v1[0] + v1[1] * v1[1]) + (v1[2] * v1[2] + v1[3] * v1[3]);
            ss = wave_sum(ss); if (F.lane == 0) red[F.wave] = ss;
            __syncthreads();
            ss = ((red[0] + red[1]) + (red[2] + red[3])) + ((red[4] + red[5]) + (red[6] + red[7]));
            __syncthreads();
            if constexpr (MODE == 7) {
                const float rstd = 1.0f / sqrtf(ss * (1.0f / DM) + EPS); const float* gf = args.in[21] + c0; float* yo = args.out + O_YP + (size_t)gr * DM + c0;
                *(f32x4*)yo = v0 * rstd * *(const f32x4*)gf; *(f32x4*)(yo + 4) = v1 * rstd * *(const f32x4*)(gf + 4);
            } else {
                if (F.tid == 0) ss_out[gr] = ss;
                u32x4 w; w.x = cvt_pk_bf16(v0[0], v0[1]); w.y = cvt_pk_bf16(v0[2], v0[3]); w.z = cvt_pk_bf16(v1[0], v1[1]); w.w = cvt_pk_bf16(v1[2], v1[3]);
                if constexpr (MODE == 3) *(u32x4*)(Aout + ((size_t)(c0 >> 4) * MROWS + gr) * 16 + (c0 & 15)) = w;
                else *(u32x4*)((char*)Aout + tiled_off(gr, c0, DM / 64)) = w;
            }
        }
    }
}

__global__ void __launch_bounds__(NWAVES * 64, 2) trunk_fwd(Args args) {
    extern __shared__ __attribute__((aligned(16))) unsigned char lds[];
    Frame F;
    F.lds = (LAS unsigned char*)lds;
    F.tid = threadIdx.x; F.lane = F.tid & 63; F.wave = __builtin_amdgcn_readfirstlane(F.tid >> 6);
    F.G = gridDim.x; { const int bx = blockIdx.x; F.vcu = (F.G % 8 == 0) ? (bx % 8) * (F.G / 8) + bx / 8 : bx; }
    volatile LAS unsigned* MISC = (volatile LAS unsigned*)(F.lds + MISC_OFF);
    unsigned char* ws = args.ws;
    unsigned* ctl = (unsigned*)(ws + WS_CTL);
    for (int u = F.tid; u < 512 / 4; u += NWAVES * 64) ((LAS unsigned*)(F.lds + LDSCTL_OFF))[u] = 0u;
    __syncthreads();
    XcdBarrier bar; bar.bar = ctl + CW_BAR; bar.x = 0; bar.st = nullptr;
    if (N_LAUNCHES == 1) bar = xcd_barrier_post(ctl + CW_BAR, MISC + 8);
#define GRID_BAR() do { if (N_LAUNCHES == 1) xcd_barrier(bar); } while (0)
    const int lo = args.ph_lo, hi = args.ph_hi;
#define IN(k) (lo <= (k) && (k) < hi)
    bf16_t* WPOOL = (bf16_t*)(ws + WS_WPOOL); bf16_t* WGLU = (bf16_t*)(ws + WS_WGLU);
    bf16_t* WUP0 = (bf16_t*)(ws + WS_WUP0); bf16_t* WUP1 = (bf16_t*)(ws + WS_WUP1); bf16_t* WDN0 = (bf16_t*)(ws + WS_WDN0); bf16_t* WDN1 = (bf16_t*)(ws + WS_WDN1);
    bf16_t* A2 = (bf16_t*)(ws + WS_X); bf16_t* A0 = (bf16_t*)(ws + WS_A0); bf16_t* A1 = (bf16_t*)(ws + WS_A1); bf16_t* HB = (bf16_t*)(ws + WS_H);
    bf16_t* SLAB = (bf16_t*)(ws + WS_SLAB); float* SS1 = (float*)(ws + WS_SS); float* SS2 = SS1 + MROWS; float* SS3 = SS2 + MROWS; float* SS4 = SS3 + MROWS;

    if (IN(0)) {
        constexpr int T_POOL = 4 * 8 * 8, T_UP = 32 * 128, T_DN = 128 * 32, T_GLU = 32 * 32;
        constexpr int NT_ALL = T_POOL + 2 * T_UP + 2 * T_DN + 2 * T_GLU;
#define T0_DESC(it_, T) do { int r = (it_); \
            if (r < T_POOL) { const int gi = r >> 6, kb = (r >> 3) & 7, nb = r & 7; T = T0Tile{args.in[6] + (size_t)gi * 1024 * 1024, 1024, 1024, nullptr, WPOOL, gi * 1024 + nb * 128, kb * 128, nb * 128}; break; } r -= T_POOL; \
            if (r < 2 * T_UP) { const int l = r / T_UP, rr = r % T_UP, kb = rr >> 7, nb = rr & 127; T = T0Tile{args.in[19] + (size_t)l * DM * DFF, DM, DFF, args.in[18] + l * DM, l ? WUP1 : WUP0, nb * 128, kb * 128, nb * 128}; break; } r -= 2 * T_UP; \
            if (r < 2 * T_DN) { const int l = r / T_DN, rr = r % T_DN, kb = rr >> 5, nb = rr & 31; T = T0Tile{args.in[20] + (size_t)l * DFF * DM, DFF, DM, nullptr, l ? WDN1 : WDN0, nb * 128, kb * 128, nb * 128}; break; } r -= 2 * T_DN; \
            { const int ab = r / T_GLU, rr = r % T_GLU, kb = rr >> 5, nb = rr & 31; T = T0Tile{args.in[ab ? 17 : 16], DM, DM, nullptr, WGLU, nb * 256 + ab * 128, kb * 128, nb * 128}; } } while (0)
        {
            unsigned* qctr = ctl + CW_Q0; volatile LAS unsigned* qw = MISC + 40;
            constexpr unsigned QEND = (unsigned)(NCHUNK + NT_ALL);
            unsigned pend = 0u;
            if (F.tid == 0) pend = q_grab(qctr);
            unsigned a = q_next(F, qw, qctr, pend), b = q_next(F, qw, qctr, pend);
            while (a < (unsigned)NCHUNK) { t1_unit(F, args, (int)a, A0); a = b; b = q_next(F, qw, qctr, pend); }
            float va[16][2], vb[16][2]; T0Tile ta, tb;
            if (a < QEND) { T0_DESC((int)a - NCHUNK, ta); t0_load(F, ta, va); }
            while (a < QEND) {
                if (b < QEND) { T0_DESC((int)b - NCHUNK, tb); t0_load(F, tb, vb); }
                const unsigned c = t0_store(F, ta, va, qw, qctr, pend);
                if (b >= QEND) break;
                if (c < QEND) { T0_DESC((int)c - NCHUNK, ta); t0_load(F, ta, va); }
                const unsigned d = t0_store(F, tb, vb, qw, qctr, pend);
                a = c; b = d;
            }
        }
#undef T0_DESC
        if (IN(1)) GRID_BAR();
    }
    if (IN(1)) {
        pg8::Gemm g{(const char*)A0, (const char*)WPOOL, DM * 2u, 32u, 1024 * 2u, 16, 4, 64, 0u};
        pg8::Sched S; S.init(16, F.G, (int)blockIdx.x, 4);
        Epi<1> E{{args.in[0], args.in[1], nullptr, A1, nullptr, nullptr, args.in[7], nullptr, SS1, SLAB, DM}};
        pg8::gemm_phase(F.lds, g, S, E);
        if (IN(2)) GRID_BAR();
    }
    if (IN(2)) { fixup_rows<1>(F, args, ws, nullptr, SS1, nullptr, A1); if (IN(3)) GRID_BAR(); }
    if (IN(3)) {
        pg8::Gemm g{(const char*)A1, (const char*)WUP0, 0u, 8192u, DM * 2u, 64, 16, 0, (DM / 64) * 32768u};
        pg8::Sched S; S.init(64, F.G, (int)blockIdx.x, 4);
        Epi<2> E{{nullptr, nullptr, nullptr, nullptr, HB, nullptr, nullptr, SS1, nullptr, SLAB, DFF}};
        pg8::gemm_phase(F.lds, g, S, E);
#if REP_UP > 1
        __syncthreads();
        pg8::gemm_phase(F.lds, g, S, E);
#endif
        if (IN(4)) GRID_BAR();
    }
    if (IN(4)) { fixup_rows<2>(F, args, ws, SS1, nullptr, nullptr, nullptr); if (IN(5)) GRID_BAR(); }
    if (IN(5)) {
        pg8::Gemm g{(const char*)HB, (const char*)WDN0, 0u, 8192u, DFF * 2u, 256, 16, 0, (DFF / 64) * 32768u};
        pg8::Sched S; S.init(16, F.G, (int)blockIdx.x, 16);
        Epi<3> E{{nullptr, nullptr, A1, A0, nullptr, nullptr, nullptr, nullptr, SS2, SLAB, DM}};
        pg8::gemm_phase(F.lds, g, S, E);
        if (IN(6)) GRID_BAR();
    }
    if (IN(6)) { fixup_rows<3>(F, args, ws, nullptr, SS2, A1, A0); if (IN(7)) GRID_BAR(); }
    if (IN(7)) {
        for (int g = F.vcu; g < NGRP; g += F.G) ssm_group(F, args, g, A0, A1, SS2, (unsigned*)(ws + WS_SG), (unsigned*)(ws + WS_HG));
#if REP_SSM > 1
        for (int g = F.vcu; g < NGRP; g += F.G) ssm_group(F, args, g, A0, A1, SS2, (unsigned*)(ws + WS_SG), (unsigned*)(ws + WS_HG));
#endif
        if (IN(8)) GRID_BAR();
    }
    if (IN(8)) {
        pg8::Gemm g{(const char*)A1, (const char*)WGLU, 32u, (unsigned)MROWS * 32u, DM * 2u, 64, 8, 0, 0u};
        pg8::Sched S; S.init(32, F.G, (int)blockIdx.x, 8);
        Epi<4> E{{nullptr, nullptr, A0, A2, nullptr, nullptr, nullptr, nullptr, SS3, SLAB, 2 * DM}};
        pg8::gemm_phase(F.lds, g, S, E);
        if (IN(9)) GRID_BAR();
    }
    if (IN(9)) { fixup_rows<5>(F, args, ws, nullptr, SS3, A0, A2); if (IN(10)) GRID_BAR(); }
    if (IN(10)) {
        pg8::Gemm g{(const char*)A2, (const char*)WUP1, 0u, 8192u, DM * 2u, 64, 16, 0, (DM / 64) * 32768u};
        pg8::Sched S; S.init(64, F.G, (int)blockIdx.x, 4);
        Epi<2> E{{nullptr, nullptr, nullptr, nullptr, HB, nullptr, nullptr, SS3, nullptr, SLAB, DFF}};
        pg8::gemm_phase(F.lds, g, S, E);
        if (IN(11)) GRID_BAR();
    }
    if (IN(11)) { fixup_rows<2>(F, args, ws, SS3, nullptr, nullptr, nullptr); if (IN(12)) GRID_BAR(); }
    if (IN(12)) {
        pg8::Gemm g{(const char*)HB, (const char*)WDN1, 0u, 8192u, DFF * 2u, 256, 16, 0, (DFF / 64) * 32768u};
        pg8::Sched S; S.init(16, F.G, (int)blockIdx.x, 16);
        Epi<5> E{{nullptr, nullptr, A2, A1, nullptr, nullptr, nullptr, nullptr, SS4, SLAB, DM}};
        pg8::gemm_phase(F.lds, g, S, E);
        if (IN(13)) GRID_BAR();
    }
    if (IN(13)) {
        fixup_rows<7>(F, args, ws, nullptr, nullptr, A2, nullptr);
        const float* gf = args.in[21];
        const int gw = F.vcu * NWAVES + F.wave, NGW = F.G * NWAVES;
        for (int m = gw; m < SEQ; m += NGW) {
            float* row = args.out + O_YP + (size_t)m * DM + F.lane * 8; const bf16_t* xr = A1 + (size_t)m * DM + F.lane * 8;
            const float r = 1.0f / sqrtf(SS4[m] * (1.0f / DM) + EPS);
#pragma unroll 4
            for (int j = 0; j < 8; ++j) { const u32x4 w = *(const u32x4*)(xr + j * 512); const f32x4 g0 = *(const f32x4*)(gf + j * 512 + F.lane * 8), g1 = *(const f32x4*)(gf + j * 512 + F.lane * 8 + 4);
                *(f32x4*)(row + j * 512) = (f32x4){bf_lo(w.x), bf_hi(w.x), bf_lo(w.y), bf_hi(w.y)} * r * g0; *(f32x4*)(row + j * 512 + 4) = (f32x4){bf_lo(w.z), bf_hi(w.z), bf_lo(w.w), bf_hi(w.w)} * r * g1; }
        }
    }
#undef IN
#undef GRID_BAR
}

extern "C" void kernel_launch(void* const* d_in, const int* in_sizes, int n_in, void* d_out, int out_size, void* d_ws, size_t ws_size, hipStream_t stream) {
    static int grid = 0;
    if (grid == 0) {
        if (n_in != 22 || in_sizes[0] != SEQ * DM || (size_t)out_size != O_END || ws_size < WS_END) {
            fprintf(stderr, "kernel_launch: unexpected shapes (n_in %d, in0 %d, out %d, ws %zu); nothing launched\n", n_in, n_in > 0 ? in_sizes[0] : -1, out_size, ws_size); grid = -1; return; }
        int dev = 0, cus = 0, per_cu = 0;
        if (hipGetDevice(&dev) != hipSuccess || hipDeviceGetAttribute(&cus, hipDeviceAttributeMultiprocessorCount, dev) != hipSuccess) { fprintf(stderr, "kernel_launch: device query failed\n"); grid = -1; return; }
        if (hipFuncSetAttribute((const void*)trunk_fwd, hipFuncAttributeMaxDynamicSharedMemorySize, LDS_BYTES) != hipSuccess) { fprintf(stderr, "kernel_launch: hipFuncSetAttribute failed\n"); grid = -1; return; }
        if (hipOccupancyMaxActiveBlocksPerMultiprocessor(&per_cu, (const void*)trunk_fwd, NWAVES * 64, LDS_BYTES) != hipSuccess || per_cu < 1)
            fprintf(stderr, "kernel_launch: note: occupancy query reports %d workgroups per CU\n", per_cu);
        (void)hipGetLastError();
        grid = cus;
    }
    if (grid < 0) return;
    if (hipMemsetAsync((char*)d_ws + WS_CTL, 0, CTL_ZERO_BYTES, stream) != hipSuccess) { fprintf(stderr, "kernel_launch: memset failed\n"); return; }
    Args a{};
    for (int i = 0; i < 22; ++i) a.in[i] = (const float*)d_in[i];
    a.out = (float*)d_out; a.ws = (unsigned char*)d_ws;
    for (int li = 0; li < N_LAUNCHES; ++li) {
        a.ph_lo = (N_LAUNCHES == 1) ? 0 : li; a.ph_hi = (N_LAUNCHES == 1) ? NPHASE : li + 1;
        hipLaunchKernelGGL(trunk_fwd, dim3(grid), dim3(NWAVES * 64), LDS_BYTES, stream, a);
        const hipError_t le = hipPeekAtLastError();
        if (le != hipSuccess) { fprintf(stderr, "kernel_launch: launch %d failed: %s\n", li, hipGetErrorName(le)); break; }
    }
}
```

```cpp
#include <hip/hip_runtime.h>
#include <cstdio>
#include <cstdint>

#define LAS __attribute__((address_space(3)))
#define GAS __attribute__((address_space(1)))
typedef unsigned short bf16_t;
typedef short bf16x8 __attribute__((ext_vector_type(8)));
typedef float f32x4 __attribute__((ext_vector_type(4)));
typedef float f32x2 __attribute__((ext_vector_type(2)));
typedef unsigned u32x4 __attribute__((ext_vector_type(4)));
typedef unsigned u32x2 __attribute__((ext_vector_type(2)));

constexpr int DM = 4096, DFF = 16384, SEQ = 8192, NB = 8, LS = 16, NSAMP = NB * LS, MROWS = SEQ + NSAMP;
constexpr int NGRP = 256, PST = 64, CG = 16;
constexpr int NCHUNK = MROWS / 16;
constexpr int NCHP = 528;
constexpr float EPS = 1e-6f;
constexpr int NWAVES = 8;
#ifndef MK_N_LAUNCHES
#define MK_N_LAUNCHES 1
#endif
constexpr int NPHASE = 14;
#ifndef REP_CONV
#define REP_CONV 1
#endif
#ifndef REP_POOL
#define REP_POOL 1
#endif
#ifndef REP_SSM
#define REP_SSM 1
#endif
#ifndef REP_UP
#define REP_UP 1
#endif
constexpr int N_LAUNCHES = MK_N_LAUNCHES;

constexpr size_t O_YP = 0, O_YS = 33554432, O_PRP = 34078720, O_PRS = 34140160, O_SRP = 34631680, O_SIP = 34648064, O_SRS = 34664448, O_SIS = 34795520, O_END = 34926592;

constexpr size_t MiB = 1u << 20;
constexpr size_t WS_CTL = 0, CTL_ZERO_BYTES = 1 * MiB;
constexpr size_t WS_SS = 512 * 1024;
constexpr size_t WS_WPOOL = 2 * MiB, WS_WGLU = 10 * MiB, WS_WUP0 = 74 * MiB, WS_WUP1 = 202 * MiB, WS_WDN0 = 330 * MiB, WS_WDN1 = 458 * MiB;
constexpr size_t WS_X = 586 * MiB, WS_A0 = 716 * MiB, WS_A1 = 781 * MiB, WS_H = 847 * MiB, WS_SG = 1111 * MiB, WS_HG = 1177 * MiB, WS_SLAB = 1210 * MiB, WS_END = 1242 * MiB;
static_assert((size_t)MROWS * DM * 4 == 130 * MiB && (size_t)MROWS * DM * 2 == 65 * MiB && (size_t)MROWS * DFF * 2 == 260 * MiB, "buffer sizes");
static_assert((size_t)NGRP * NCHP * 128 * 4 == 66 * MiB && (size_t)NGRP * NCHP * 128 * 2 == 33 * MiB, "ssm scratch sizes");
constexpr int CW_Q0 = 128;
constexpr int CW_BAR = 4096;

constexpr int RING_BYTES = 131072, LDS_BYTES = 163840, LDSCTL_OFF = LDS_BYTES - 512, MISC_OFF = LDSCTL_OFF + 320;

__device__ __forceinline__ unsigned f2bf(float f) { unsigned u = __builtin_bit_cast(unsigned, f); return (u + 0x7fffu + ((u >> 16) & 1u)) >> 16; }
__device__ __forceinline__ unsigned pk2(float lo, float hi) { return f2bf(lo) | (f2bf(hi) << 16); }
__device__ __forceinline__ unsigned cvt_pk_bf16(float lo, float hi) { unsigned r; asm volatile("v_cvt_pk_bf16_f32 %0, %1, %2" : "=v"(r) : "v"(lo), "v"(hi)); return r; }
typedef __bf16 bf16x2_t __attribute__((ext_vector_type(2)));
__device__ __forceinline__ unsigned cvt_pk_bf16_c(float lo, float hi) { return __builtin_bit_cast(unsigned, __builtin_convertvector((f32x2){lo, hi}, bf16x2_t)); }
__device__ __forceinline__ float bf_lo(unsigned w) { return __builtin_bit_cast(float, w << 16); }
__device__ __forceinline__ float bf_hi(unsigned w) { return __builtin_bit_cast(float, w & 0xffff0000u); }

namespace pg8 {
constexpr int BM = 256, BK = 64, HALF = 128, HTB = HALF * BK * 2, STAGE_BYTES = 8 * HTB;
__host__ __device__ __forceinline__ int lds_byte(int r, int c) { const int st = (r >> 4) * 2 + (c >> 5), rr = r & 15, cc = c & 31, ob = rr * 64 + cc * 2; return st * 1024 + (ob ^ (((ob >> 9) & 1) << 5)); }
__host__ __device__ __forceinline__ void stage_rc(int b, int& R, int& C) { const int st = b / 1024, sb = b % 1024, swz = sb ^ (((sb >> 9) & 1) << 5); R = (st >> 1) * 16 + swz / 64; C = (st & 1) * 32 + (swz % 64) / 2; }
__host__ __device__ __forceinline__ int perm32(int rho) { const int n = rho >> 4, i = rho & 15; return 8 * (i >> 2) + 4 * n + (i & 3); }

struct Unit { int pm, pn, kind, ks; };
struct Gemm {
    const char* A; const char* Bt;
    unsigned a_rs, a_gs, b_rs;
    int nt_full, nt_split;
    int a_kgrp_pn4;
    unsigned a_ts;
};
struct Sched {
    int nN, G, c, nsplit, nwg;
    __device__ __forceinline__ void init(int nN_, int G_, int c_, int nsplit_) { nN = nN_; G = G_; c = c_; nsplit = nsplit_; nwg = 32 * nN_; }
    __device__ __forceinline__ bool next(int i, Unit& u) const {
        const long L = (long)i * G + c;
        const bool prompt = L < nwg;
        int wgid = prompt ? (int)L : 0; { const int q = nwg / 8, xcd = wgid % 8, off = wgid / 8; wgid = xcd * q + off; }
        const int nig = 8 * nN, gid = wgid / nig, fm = gid * 8;
        const int s = prompt ? 0 : (int)(L - nwg);
        const int pm_ = prompt ? fm + ((wgid % nig) % 8) : 32, pn_ = prompt ? (wgid % nig) / 8 : s / nsplit, kind_ = prompt ? 0 : 1, ks_ = prompt ? 0 : s % nsplit;
        u.pm = pm_; u.pn = pn_; u.kind = kind_; u.ks = ks_;
        return prompt || (L - nwg) < (long)nN * nsplit;
    }
};

template <class Epi>
__device__ __forceinline__ void gemm_phase(LAS unsigned char* lds, const Gemm g, const Sched& S, const Epi& E) {
    const int tid = threadIdx.x, wid = __builtin_amdgcn_readfirstlane(tid >> 6), lane = tid & 63, wr = wid >> 2, wc = wid & 3, fr = lane & 15, fq = lane >> 4;
    unsigned voffA[2], voffB[2];
#pragma unroll
    for (int i = 0; i < 2; ++i) { int R, C; stage_rc(tid * 16 + i * 8192, R, C); const int Rb = Epi::PERM ? ((R & ~31) + perm32(R & 31)) : R;
        voffA[i] = g.a_rs ? (unsigned)R * g.a_rs + (unsigned)(C >> 4) * g.a_gs + (unsigned)(C & 15) * 2u : (unsigned)(tid * 16 + i * 8192); voffB[i] = (unsigned)(tid * 16 + i * 8192); (void)Rb; }
    const size_t akstep = (size_t)g.a_gs * 4, bkstep = (size_t)(2 * HTB);
    const size_t ahstep = g.a_rs ? (size_t)HALF * g.a_rs : (size_t)HTB, bhstep = (size_t)HTB;
    const size_t atstep = g.a_rs ? 2 * ahstep : (size_t)g.a_ts, btstep = (size_t)256 * g.b_rs;
    const unsigned ldsw = (unsigned)wid * 1024u;
    const int aoff = lds_byte(wr * 64 + fr, fq * 8), boff = lds_byte(wc * 32 + fr, fq * 8);
#define PG8_SA(b, h) (((b) * 2 + (h)) * HTB)
#define PG8_SB(b, h) ((4 + (b) * 2 + (h)) * HTB)
#define PG8_STAGE(bufoff, gbase, voff) do { _Pragma("unroll") for (int _i = 0; _i < 2; ++_i) \
        __builtin_amdgcn_global_load_lds((const unsigned*)((const char*)(gbase) + (voff)[_i]), (LAS unsigned*)(lds + (bufoff) + ldsw + _i * 8192), 16, 0, 0); } while (0)
#define PG8_LDA(dst, b, h) do { _Pragma("unroll") for (int m = 0; m < 4; ++m) _Pragma("unroll") for (int k = 0; k < 2; ++k) dst[m][k] = *(const LAS bf16x8*)(lds + PG8_SA(b, h) + aoff + m * 2048 + k * 1024); } while (0)
#define PG8_LDB(dst, b, h) do { _Pragma("unroll") for (int n = 0; n < 2; ++n) _Pragma("unroll") for (int k = 0; k < 2; ++k) dst[n][k] = *(const LAS bf16x8*)(lds + PG8_SB(b, h) + boff + n * 2048 + k * 1024); } while (0)
#define PG8_MMA(ai, bj, At, Bt) do { __builtin_amdgcn_s_setprio(1); _Pragma("unroll") for (int m = 0; m < 4; ++m) _Pragma("unroll") for (int n = 0; n < 2; ++n) _Pragma("unroll") for (int k = 0; k < 2; ++k) \
        acc[ai][bj][m][n] = __builtin_amdgcn_mfma_f32_16x16x32_bf16(Bt[n][k], At[m][k], acc[ai][bj][m][n], 0, 0, 0); __builtin_amdgcn_s_setprio(0); } while (0)
#define PG8_WAIT_V(n) asm volatile("s_waitcnt vmcnt(" #n ")" ::: "memory")
#define PG8_WAIT_L(n) asm volatile("s_waitcnt lgkmcnt(" #n ")" ::: "memory")
#define PG8_BAR __builtin_amdgcn_s_barrier()
#define PG8_SCHED __builtin_amdgcn_sched_barrier(0)
#define PG8_UNIT_PTRS(u, pA, pB, hs, ntu) do { const int _nt = (u).kind ? g.nt_split : g.nt_full; \
        pA = g.A + (size_t)(u).pm * atstep + ((size_t)((u).pn >> 2) * g.a_kgrp_pn4 + (size_t)(u).ks * _nt * 4) * g.a_gs; \
        pB = g.Bt + (size_t)(u).pn * btstep + (size_t)(u).ks * _nt * bkstep; hs = (u).kind ? (size_t)0 : ahstep; ntu = _nt; } while (0)
    Unit cur, nxt; int ui = 0; bool st16 = false;
    if (!S.next(0, cur)) return;
    f32x4 acc[2][2][4][2];
#pragma unroll
    for (int a = 0; a < 2; ++a)
#pragma unroll
        for (int b = 0; b < 2; ++b)
#pragma unroll
            for (int m = 0; m < 4; ++m)
#pragma unroll
                for (int n = 0; n < 2; ++n) acc[a][b][m][n] = (f32x4){0.f, 0.f, 0.f, 0.f};
    bf16x8 At[4][2], B0[2][2], B1[2][2];
    const char* cA; const char* cB; size_t cH; int nt;
    PG8_UNIT_PTRS(cur, cA, cB, cH, nt);
    PG8_STAGE(PG8_SB(0, 0), cB, voffB); PG8_STAGE(PG8_SB(0, 1), cB + bhstep, voffB); PG8_STAGE(PG8_SA(0, 0), cA, voffA); PG8_STAGE(PG8_SA(0, 1), cA + cH, voffA);
    if (wr == 1) PG8_BAR;
    PG8_WAIT_V(2); PG8_BAR;
    PG8_STAGE(PG8_SB(1, 0), cB + bkstep, voffB); PG8_STAGE(PG8_SA(1, 0), cA + akstep, voffA); PG8_STAGE(PG8_SB(1, 1), cB + bhstep + bkstep, voffB);
    PG8_WAIT_V(6); PG8_BAR;
    for (;;) {
        const bool has_next = S.next(ui + 1, nxt);
        const char* nA = cA; const char* nB = cB; size_t nH = cH; int nnt = nt;
        if (has_next) PG8_UNIT_PTRS(nxt, nA, nB, nH, nnt);
#define PG8_ITER(FULL, W1, W2) { \
            const bool last = (t == nt - 2); \
            const char* a1 = cA + (size_t)(t + 1) * akstep; \
            const char* a2 = last ? nA : cA + (size_t)(t + 2) * akstep; const char* b2 = last ? nB : cB + (size_t)(t + 2) * bkstep; \
            const size_t h2 = last ? nH : cH; \
            const char* a3 = a2 + akstep; const char* b3 = b2 + bkstep; \
              \
            PG8_LDB(B0, 0, 0); PG8_LDB(B1, 0, 1); PG8_SCHED; PG8_LDA(At, 0, 0); PG8_STAGE(PG8_SA(1, 1), a1 + cH, voffA); \
            PG8_WAIT_V(W1); PG8_WAIT_L(0); PG8_BAR; PG8_MMA(0, 0, At, B0); PG8_MMA(0, 1, At, B1); PG8_BAR; PG8_SCHED; \
              \
            if (FULL) PG8_LDA(At, 0, 1); PG8_STAGE(PG8_SB(0, 0), b2, voffB); PG8_STAGE(PG8_SB(0, 1), b2 + bhstep, voffB); PG8_STAGE(PG8_SA(0, 0), a2, voffA); \
            PG8_WAIT_V(W2); PG8_WAIT_L(0); PG8_BAR; if (FULL) { PG8_MMA(1, 0, At, B0); PG8_MMA(1, 1, At, B1); } PG8_BAR; PG8_SCHED; \
              \
            PG8_LDB(B0, 1, 0); PG8_LDB(B1, 1, 1); PG8_SCHED; PG8_LDA(At, 1, 0); PG8_STAGE(PG8_SA(0, 1), a2 + h2, voffA); \
            PG8_WAIT_V(8); PG8_WAIT_L(0); PG8_BAR; PG8_MMA(0, 0, At, B0); PG8_MMA(0, 1, At, B1); PG8_BAR; PG8_SCHED; \
              \
            if (FULL) PG8_LDA(At, 1, 1); PG8_STAGE(PG8_SB(1, 0), b3, voffB); PG8_STAGE(PG8_SB(1, 1), b3 + bhstep, voffB); PG8_STAGE(PG8_SA(1, 0), a3, voffA); \
            PG8_WAIT_V(8); PG8_WAIT_L(0); PG8_BAR; if (FULL) { PG8_MMA(1, 0, At, B0); PG8_MMA(1, 1, At, B1); } PG8_BAR; PG8_SCHED; }
#define PG8_KLOOP(FULL) { for (int t = 0; t < nt; t += 2) PG8_ITER(FULL, 8, 8) }
        if (cur.kind == 0) PG8_KLOOP(true) else PG8_KLOOP(false)
#undef PG8_KLOOP
#undef PG8_ITER
        if (wr == 0) PG8_BAR;
        E(acc, cur, wr, wc, fr, fq);
        if (!has_next) break;
#pragma unroll
        for (int a = 0; a < 2; ++a)
#pragma unroll
            for (int b = 0; b < 2; ++b)
#pragma unroll
                for (int m = 0; m < 4; ++m)
#pragma unroll
                    for (int n = 0; n < 2; ++n) acc[a][b][m][n] = (f32x4){0.f, 0.f, 0.f, 0.f};
        st16 = Epi::ST16 || cur.kind != 0;
        cur = nxt; cA = nA; cB = nB; cH = nH; nt = nnt; ++ui;
        if (wr == 1) PG8_BAR;
    }
    PG8_WAIT_V(0);
    PG8_BAR;
#undef PG8_SA
#undef PG8_SB
#undef PG8_STAGE
#undef PG8_LDA
#undef PG8_LDB
#undef PG8_MMA
#undef PG8_WAIT_V
#undef PG8_WAIT_L
#undef PG8_BAR
#undef PG8_SCHED
#undef PG8_UNIT_PTRS
}
}

__device__ __forceinline__ size_t tiled_off(int row, int col, int nkt) { return (((size_t)(row >> 8) * nkt + (col >> 6)) * 2 + ((row >> 7) & 1)) * (size_t)pg8::HTB + pg8::lds_byte(row & 127, col & 63); }
struct EpiArgs {
    const float* xin_p; const float* xin_s; const bf16_t* Rin; bf16_t* Aout; bf16_t* H; float* outy; const float* vec; const float* ss_in; float* ss_out; bf16_t* slab; int slab_ld;
};
__device__ __forceinline__ float sigmoidf_(float x) { return __builtin_amdgcn_rcpf(1.0f + __expf(-x)); }
template <int MODE> struct Epi {
    static constexpr bool PERM = true, ST16 = (MODE == 2);
    EpiArgs a;
    __device__ __forceinline__ void operator()(const f32x4 (&acc)[2][2][4][2], const pg8::Unit& u, int wr, int wc, int fr, int fq) const {
        const int colb = u.pn * 256 + wc * 32 + 8 * fq;
        if (u.kind != 0) {
            bf16_t* sl = a.slab + (size_t)u.ks * NSAMP * a.slab_ld + colb;
#pragma unroll
            for (int m = 0; m < 4; ++m) { bf16_t* rp = sl + (size_t)(wr * 64 + m * 16 + fr) * a.slab_ld;
#pragma unroll
                for (int bj = 0; bj < 2; ++bj) { const f32x4 v0 = acc[0][bj][m][0], v1 = acc[0][bj][m][1];
                    u32x4 w; w.x = cvt_pk_bf16_c(v0[0], v0[1]); w.y = cvt_pk_bf16_c(v0[2], v0[3]); w.z = cvt_pk_bf16_c(v1[0], v1[1]); w.w = cvt_pk_bf16_c(v1[2], v1[3]);
                    *(u32x4*)(rp + 128 * bj) = w; } }
            return;
        }
#define SSQ8(v0, v1) ((v0[0] * v0[0] + v0[1] * v0[1]) + (v0[2] * v0[2] + v0[3] * v0[3]) + (v1[0] * v1[0] + v1[1] * v1[1]) + (v1[2] * v1[2] + v1[3] * v1[3]))
        float rs8[2][4];
        if constexpr (MODE == 2) {
#pragma unroll
            for (int ai = 0; ai < 2; ++ai)
#pragma unroll
                for (int m = 0; m < 4; ++m) rs8[ai][m] = a.ss_in[u.pm * 256 + ai * 128 + wr * 64 + fr + 16 * m]; }
#pragma unroll
        for (int ai = 0; ai < 2; ++ai) {
            const int gr0 = u.pm * 256 + ai * 128 + wr * 64 + fr;
            if constexpr (MODE == 2) {
#pragma unroll
                for (int m = 0; m < 4; ++m) { const float r = __builtin_amdgcn_rsqf(rs8[ai][m] * (1.0f / DM) + EPS);
#pragma unroll
                    for (int bj = 0; bj < 2; ++bj) { const int col = colb + 128 * bj;
                        const f32x4 z4 = (f32x4){0.f, 0.f, 0.f, 0.f};
                        const f32x4 p0 = __builtin_elementwise_max(acc[ai][bj][m][0], z4) * r, p1 = __builtin_elementwise_max(acc[ai][bj][m][1], z4) * r;
                        const f32x4 v0 = p0 * p0, v1 = p1 * p1;
                        u32x4 w; w.x = cvt_pk_bf16(v0[0], v0[1]); w.y = cvt_pk_bf16(v0[2], v0[3]); w.z = cvt_pk_bf16(v1[0], v1[1]); w.w = cvt_pk_bf16(v1[2], v1[3]);
                        *(u32x4*)((char*)a.H + tiled_off(gr0 + 16 * m, col, DFF / 64)) = w; } }
            } else {
                const int col4 = u.pn * 128 + wc * 32 + 8 * fq;
                f32x4 vs[2][2];
                if constexpr (MODE == 1) {
#pragma unroll
                    for (int bj = 0; bj < 2; ++bj) { vs[bj][0] = *(const f32x4*)(a.vec + colb + 128 * bj); vs[bj][1] = *(const f32x4*)(a.vec + colb + 128 * bj + 4); } }
                constexpr int NBJ = (MODE == 4) ? 1 : 2;
                constexpr int MB = (MODE == 1) ? 2 : 4;
#pragma unroll
                for (int mh = 0; mh < 4 / MB; ++mh) {
                    f32x4 xf[MODE == 1 ? MB : 1][2][2]; u32x4 xr4[MODE == 1 ? 1 : MB][NBJ];
#pragma unroll
                    for (int mm = 0; mm < MB; ++mm) { const int gr = gr0 + 16 * (MB * mh + mm);
#pragma unroll
                        for (int bj = 0; bj < NBJ; ++bj) {
                            if constexpr (MODE == 1) { const float* xr = ((gr < SEQ) ? a.xin_p + (size_t)gr * DM : a.xin_s + (size_t)(gr - SEQ) * DM) + colb + 128 * bj; xf[mm][bj][0] = *(const f32x4*)xr; xf[mm][bj][1] = *(const f32x4*)(xr + 4); }
                            else { const int col = (MODE == 4) ? col4 : colb + 128 * bj;
                                xr4[mm][bj] = (MODE == 4) ? *(const u32x4*)(a.Rin + ((size_t)(col >> 4) * MROWS + gr) * 16 + (col & 15)) : *(const u32x4*)((const char*)a.Rin + tiled_off(gr, col, DM / 64)); } } }
#pragma unroll
                    for (int mm = 0; mm < MB; ++mm) { const int m = MB * mh + mm, gr = gr0 + 16 * m; float ss = 0.f;
#pragma unroll
                        for (int bj = 0; bj < NBJ; ++bj) { const int col = (MODE == 4) ? col4 : colb + 128 * bj;
                            f32x4 v0, v1;
                            if constexpr (MODE == 1) { v0 = xf[mm][bj][0] + vs[bj][0] * acc[ai][bj][m][0]; v1 = xf[mm][bj][1] + vs[bj][1] * acc[ai][bj][m][1]; }
                            else { const u32x4 rw = xr4[mm][bj]; v0 = (f32x4){bf_lo(rw.x), bf_hi(rw.x), bf_lo(rw.y), bf_hi(rw.y)}; v1 = (f32x4){bf_lo(rw.z), bf_hi(rw.z), bf_lo(rw.w), bf_hi(rw.w)};
                                if constexpr (MODE == 4) {
#pragma unroll
                                    for (int j = 0; j < 4; ++j) { v0[j] += acc[ai][0][m][0][j] * sigmoidf_(acc[ai][1][m][0][j]); v1[j] += acc[ai][0][m][1][j] * sigmoidf_(acc[ai][1][m][1][j]); } }
                                else { v0 += acc[ai][bj][m][0]; v1 += acc[ai][bj][m][1]; } }
                            ss += SSQ8(v0, v1);
                            u32x4 w; w.x = cvt_pk_bf16(v0[0], v0[1]); w.y = cvt_pk_bf16(v0[2], v0[3]); w.z = cvt_pk_bf16(v1[0], v1[1]); w.w = cvt_pk_bf16(v1[2], v1[3]);
                            if constexpr (MODE == 3) *(u32x4*)(a.Aout + ((size_t)(col >> 4) * MROWS + gr) * 16 + (col & 15)) = w;
                            else if constexpr (MODE == 5) *(u32x4*)(a.Aout + (size_t)gr * DM + col) = w;
                            else *(u32x4*)((char*)a.Aout + tiled_off(gr, col, DM / 64)) = w;
                        }
                        ss += __shfl_xor(ss, 16); ss += __shfl_xor(ss, 32);
                        if (fq == 0) unsafeAtomicAdd(a.ss_out + gr, ss); }
                }
            }
        }
#undef SSQ8
    }
};

typedef GAS unsigned gu32;
#define RLX_AGENT __ATOMIC_RELAXED, __HIP_MEMORY_SCOPE_AGENT
#define XB_TMO      128
#define XB_XCNT(j)  (256  + 64 * (j))
#define XB_XSUB(j)  (1280 + 64 * (j))
#define XB_XGEN(j)  (2304 + 64 * (j))
#define XB_TOP      3328
#define XB_TOPGEN   3392
#define XCD_BAR_WORDS 3456
#define XB_SPIN_CAP (1u << 18)
__device__ __forceinline__ unsigned xb_ld(unsigned* p)              { return __hip_atomic_load(p, __ATOMIC_RELAXED, __HIP_MEMORY_SCOPE_AGENT); }
__device__ __forceinline__ unsigned xb_add(unsigned* p, unsigned v) { return __hip_atomic_fetch_add(p, v, __ATOMIC_RELAXED, __HIP_MEMORY_SCOPE_AGENT); }
__device__ __forceinline__ unsigned xb_xcc_id() { return (unsigned)__builtin_amdgcn_s_getreg((3 << 11) | 20) & 0xFu; }
#define XB_SPIN(cond, bar) do { unsigned _sp = 0; while (cond) { __builtin_amdgcn_s_sleep(1); \
    if ((++_sp & 255u) == 0u) { if (xb_ld(&(bar)[XB_TMO])) break; if (_sp > XB_SPIN_CAP) { atomicAdd(&(bar)[XB_TMO], 1u); break; } } } } while (0)
struct XcdBarrier { unsigned* bar; unsigned x; volatile LAS unsigned* st; };
__device__ __forceinline__ XcdBarrier xcd_barrier_post(unsigned* bar, volatile LAS unsigned* st) {
    XcdBarrier b; b.bar = bar; b.x = xb_xcc_id(); b.st = st;
    if (threadIdx.x == 0) (void)xb_add(&bar[XB_XCNT(b.x)], 1u);
    return b;
}
__device__ __forceinline__ void xcd_barrier_complete(unsigned* bar, unsigned x, unsigned& nloc, unsigned& nx) {
    const unsigned G = gridDim.x * gridDim.y * gridDim.z;
    unsigned sum, cnt, mine, sp = 0u;
    for (;;) {
        sum = 0u; cnt = 0u; mine = 0u;
#pragma unroll
        for (unsigned j = 0; j < 16; ++j) { const unsigned c = xb_ld(&bar[XB_XCNT(j)]); sum += c; cnt += (c > 0u) ? 1u : 0u; mine = (j == x) ? c : mine; }
        if (sum == G) break;
        __builtin_amdgcn_s_sleep(1);
        if ((++sp & 255u) == 0u) { if (xb_ld(&bar[XB_TMO])) break; if (sp > XB_SPIN_CAP) { atomicAdd(&bar[XB_TMO], 1u); break; } }
    }
    nloc = mine > 0u ? mine : 1u; nx = cnt > 0u ? cnt : 1u;
}
__device__ __forceinline__ void xcd_barrier(const XcdBarrier& b) {
    asm volatile("s_waitcnt vmcnt(0)" ::: "memory");
    __syncthreads();
    if (threadIdx.x == 0) {
        unsigned* bar = b.bar;
        __builtin_amdgcn_s_waitcnt(0);
        unsigned nloc = b.st[0], nx = b.st[1];
        if (nloc == 0u) { xcd_barrier_complete(bar, b.x, nloc, nx); b.st[0] = nloc; b.st[1] = nx; }
        const unsigned old = xb_add(&bar[XB_XSUB(b.x)], 1u);
        const unsigned gen = old / nloc;
        if (old + 1u == (gen + 1u) * nloc) {
            __builtin_amdgcn_fence(__ATOMIC_RELEASE, "agent");
            asm volatile("s_waitcnt vmcnt(0)" ::: "memory");
            const unsigned og = xb_add(&bar[XB_TOP], 1u);
            const unsigned tg = og / nx;
            if (og + 1u == (tg + 1u) * nx) xb_add(&bar[XB_TOPGEN], 1u);
            else XB_SPIN(xb_ld(&bar[XB_TOPGEN]) == tg, bar);
            __builtin_amdgcn_fence(__ATOMIC_ACQUIRE, "agent");
            xb_add(&bar[XB_XGEN(b.x)], 1u);
            asm volatile("s_waitcnt vmcnt(0)" ::: "memory");
        } else {
            XB_SPIN(xb_ld(&bar[XB_XGEN(b.x)]) == gen, bar);
            __builtin_amdgcn_fence(__ATOMIC_ACQUIRE, "agent");
            asm volatile("s_waitcnt vmcnt(0)" ::: "memory");
        }
    }
    __syncthreads();
}

struct Args { const float* in[22]; float* out; unsigned char* ws; int ph_lo, ph_hi; };
struct Frame {
    LAS unsigned char* lds; int tid, lane, wave, vcu, G;
};
__device__ __forceinline__ float wave_sum(float v) {
#pragma unroll
    for (int o = 1; o < 64; o <<= 1) v += __shfl_xor(v, o);
    return v;
}

__device__ __forceinline__ unsigned q_grab(unsigned* ctr) { return __hip_atomic_fetch_add(ctr, 1u, __ATOMIC_RELAXED, __HIP_MEMORY_SCOPE_AGENT); }
__device__ __forceinline__ unsigned q_next(Frame& F, volatile LAS unsigned* qw, unsigned* ctr, unsigned& pend) {
    if (F.tid == 0) { *qw = pend; pend = q_grab(ctr); }
    __syncthreads();
    const unsigned v = *qw;
    __syncthreads();
    return (unsigned)__builtin_amdgcn_readfirstlane((int)v);
}
constexpr int T0_PITCH = 264;
struct T0Tile { const float* W; int K, N; const float* gk; bf16_t* D; int drow0, k0, n0; };
__device__ __forceinline__ void t0_load(Frame& F, const T0Tile& t, float (&v)[16][2]) {
    const float* src = t.W + (size_t)(t.k0 + F.wave * 16) * t.N + t.n0 + F.lane;
#pragma unroll
    for (int i = 0; i < 16; ++i) { v[i][0] = src[(size_t)i * t.N]; v[i][1] = src[(size_t)i * t.N + 64]; }
}
__device__ __forceinline__ unsigned t0_store(Frame& F, const T0Tile& t, const float (&v)[16][2], volatile LAS unsigned* qw, unsigned* ctr, unsigned& pend) {
#pragma unroll
    for (int i = 0; i < 8; ++i) {
        const int kk = F.wave * 16 + 2 * i;
        const float g0 = t.gk ? t.gk[t.k0 + kk] : 1.f, g1 = t.gk ? t.gk[t.k0 + kk + 1] : 1.f;
#pragma unroll
        for (int j = 0; j < 2; ++j) *(LAS unsigned*)(F.lds + (F.lane + 64 * j) * T0_PITCH + kk * 2) = pk2(v[2 * i][j] * g0, v[2 * i + 1][j] * g1);
    }
    if (F.tid == 0) { *qw = pend; pend = q_grab(ctr); }
    __syncthreads();
    const unsigned nxt = *qw;
    const int n = F.tid >> 2, c = F.tid & 3;
#pragma unroll
    for (int i = 0; i < 4; ++i) {
        const int off = i * 64 + c * 16;
        const u32x2 lo = *(const LAS u32x2*)(F.lds + n * T0_PITCH + off), hi = *(const LAS u32x2*)(F.lds + n * T0_PITCH + off + 8);
        u32x4 w; w.x = lo.x; w.y = lo.y; w.z = hi.x; w.w = hi.y;
        const int gn = t.drow0 + n, rw = gn & 127, w5 = rw & 31, R = (rw & ~31) + 16 * ((w5 >> 2) & 1) + 4 * (w5 >> 3) + (w5 & 3), kk = t.k0 + (off >> 1);
        const size_t tile = ((size_t)(gn >> 8) * (t.K >> 6) + (kk >> 6)) * 2 + ((gn >> 7) & 1);
        *(u32x4*)((char*)t.D + tile * 16384 + pg8::lds_byte(R, kk & 63)) = w;
    }
    __syncthreads();
    return (unsigned)__builtin_amdgcn_readfirstlane((int)nxt);
}

__device__ __forceinline__ void t1_unit(Frame& F, const Args& args, int un, bf16_t* A0) {
    const float* xp = args.in[0]; const float* xs = args.in[1]; const float* cache = args.in[2]; const float* g0p = args.in[5];
    const bool samp = un >= SEQ / 16; const int b = un - SEQ / 16, t0 = samp ? 0 : un * 16;
    LAS float* rs = (LAS float*)(F.lds);
    for (int e = F.wave; e < 31; e += NWAVES) {
        const int t = t0 - 15 + e; float r = 0.f;
        if (t >= 0) { const float* xr = samp ? xs + ((size_t)b * LS + t) * DM : xp + (size_t)t * DM; float s = 0.f;
#pragma unroll 4
            for (int j = 0; j < 16; ++j) { const f32x4 q = *(const f32x4*)(xr + j * 256 + F.lane * 4); s += (q[0] * q[0] + q[1] * q[1]) + (q[2] * q[2] + q[3] * q[3]); }
            r = 1.0f / sqrtf(wave_sum(s) * (1.0f / DM) + EPS); }
        if (F.lane == 0) rs[e] = r;
    }
    __syncthreads();
    const int ch0 = F.tid * 8, w = 2 << (F.tid >> 7);
    const f32x4 ga = *(const f32x4*)(g0p + ch0), gb = *(const f32x4*)(g0p + ch0 + 4);
#define T1_FETCH(e, o0, o1) do { const int _t = t0 - 15 + (e); \
        if (_t >= 0) { const float* _xr = (samp ? xs + ((size_t)b * LS + _t) * DM : xp + (size_t)_t * DM) + ch0; const float _r = rs[(e)]; \
            o0 = *(const f32x4*)_xr * _r * ga; o1 = *(const f32x4*)(_xr + 4) * _r * gb; } \
        else if (samp) { const float* _hr = cache + ((size_t)b * 15 + (e)) * DM + ch0; o0 = *(const f32x4*)_hr; o1 = *(const f32x4*)(_hr + 4); } \
        else { o0 = (f32x4){0.f, 0.f, 0.f, 0.f}; o1 = o0; } } while (0)
    f32x4 s0 = (f32x4){0.f, 0.f, 0.f, 0.f}, s1 = s0;
    for (int e = 16 - w; e < 15; ++e) { f32x4 q0, q1; T1_FETCH(e, q0, q1); s0 += q0; s1 += q1; }
    for (int r = 0; r < 16; ++r) {
        const int e = 15 + r, t = t0 + r; f32x4 c0, c1; T1_FETCH(e, c0, c1); s0 += c0; s1 += c1;
        const float inv = 1.0f / (float)(samp ? w : (t + 1 < w ? t + 1 : w));
        const f32x4 p0 = s0 * inv - c0, p1 = s1 * inv - c1;
        const size_t gr = samp ? (size_t)SEQ + b * LS + t : (size_t)t;
        u32x4 o; o.x = pk2(p0[0], p0[1]); o.y = pk2(p0[2], p0[3]); o.z = pk2(p1[0], p1[1]); o.w = pk2(p1[2], p1[3]);
        *(u32x4*)(A0 + gr * DM + ch0) = o;
        if (samp) { if (r >= 1) { float* po = args.out + O_PRS + ((size_t)b * 15 + (r - 1)) * DM + ch0; *(f32x4*)po = c0; *(f32x4*)(po + 4) = c1; } }
        else if (t >= SEQ - 15) { float* po = args.out + O_PRP + (size_t)(t - (SEQ - 15)) * DM + ch0; *(f32x4*)po = c0; *(f32x4*)(po + 4) = c1; }
        f32x4 q0, q1; T1_FETCH(e - w + 1, q0, q1); s0 -= q0; s1 -= q1;
    }
#undef T1_FETCH
    __syncthreads();
}

constexpr int L_AP = 0, L_APT = 8704, L_BB = 17408, L_CC = 25600, L_CCT = 33792, L_KT = 41984, L_DD = 50176, L_XW = 50432, L_RS = 54528, L_TAB = 87808;
constexpr int FT_PITCH = 528, ET_PITCH = 272;
static_assert(L_TAB + 272 * ET_PITCH <= LDSCTL_OFF && L_TAB + 128 * FT_PITCH <= LDSCTL_OFF && 16 * ET_PITCH <= L_BB - L_APT, "SSM LDS map");
__device__ __forceinline__ f32x2 cmul(f32x2 a, f32x2 b) { return (f32x2){a.x * b.x - a.y * b.y, a.x * b.y + a.y * b.x}; }
__device__ __forceinline__ float gelu_tanh(float x) {
    constexpr float k1 = -2.0f * 0.7978845608028654f * 1.4426950408889634f, k2 = k1 * 0.044715f;
    const float e = __builtin_amdgcn_exp2f(x * __builtin_fmaf(k2, x * x, k1));
    return x * __builtin_amdgcn_rcpf(1.0f + e);
}
__device__ __forceinline__ void ssm_load_u(const bf16_t* Ug, int mt, int fr, int q, u32x4 (&raw)[8]) {
    const int chunk = mt * 16 + fr; const bool valid = chunk < NCHUNK;
#pragma unroll
    for (int ks = 0; ks < 8; ++ks) raw[ks] = valid ? *(const u32x4*)(Ug + ((size_t)chunk * 16 + 2 * ks + (q >> 1)) * 16 + (q & 1) * 8) : (u32x4){0u, 0u, 0u, 0u};
}
__device__ __forceinline__ void ssm_load_h(const unsigned* Hg, int mt, int fr, int q, u32x4 (&hw)[4]) {
    const int chunk = mt * 16 + fr; const bool valid = chunk < NCHUNK;
#pragma unroll
    for (int kh = 0; kh < 4; ++kh) hw[kh] = valid ? *(const u32x4*)(Hg + (size_t)chunk * 64 + kh * 16 + q * 4) : (u32x4){0u, 0u, 0u, 0u};
}
__device__ __forceinline__ bf16x8 ssm_scale(const u32x4 raw, float r, const float (&g8)[8]) {
    u32x4 w; w.x = cvt_pk_bf16_c(bf_lo(raw.x) * (r * g8[0]), bf_hi(raw.x) * (r * g8[1])); w.y = cvt_pk_bf16_c(bf_lo(raw.y) * (r * g8[2]), bf_hi(raw.y) * (r * g8[3]));
    w.z = cvt_pk_bf16_c(bf_lo(raw.z) * (r * g8[4]), bf_hi(raw.z) * (r * g8[5])); w.w = cvt_pk_bf16_c(bf_lo(raw.w) * (r * g8[6]), bf_hi(raw.w) * (r * g8[7]));
    return __builtin_bit_cast(bf16x8, w);
}
__device__ __forceinline__ void ssm_s_tile(const u32x4 (&raw)[8], const float (&g8)[8], int mt, int fr, int q, const LAS float* RS, const LAS unsigned char* TAB, unsigned* Sg) {
    const int chunk = mt * 16 + fr; const bool valid = chunk < NCHUNK;
    f32x4 acc[8];
#pragma unroll
    for (int i = 0; i < 8; ++i) acc[i] = (f32x4){0.f, 0.f, 0.f, 0.f};
#pragma unroll
    for (int ks = 0; ks < 8; ++ks) {
        const bf16x8 af = ssm_scale(raw[ks], valid ? RS[chunk * 16 + 2 * ks + (q >> 1)] : 0.f, g8);
#pragma unroll
        for (int nt = 0; nt < 8; ++nt) { const bf16x8 bfr = *(const LAS bf16x8*)(TAB + (nt * 16 + fr) * FT_PITCH + (ks * 32 + q * 8) * 2);
            acc[nt] = __builtin_amdgcn_mfma_f32_16x16x32_bf16(bfr, af, acc[nt], 0, 0, 0); }
    }
    asm volatile("s_nop 7\n\ts_nop 7" : "+v"(acc[0]), "+v"(acc[1]), "+v"(acc[2]), "+v"(acc[3]), "+v"(acc[4]), "+v"(acc[5]), "+v"(acc[6]), "+v"(acc[7]));
#pragma unroll
    for (int nt = 0; nt < 4; ++nt) { u32x4 w;
        w.x = cvt_pk_bf16(acc[nt][0], acc[nt + 4][0]); w.y = cvt_pk_bf16(acc[nt][1], acc[nt + 4][1]); w.z = cvt_pk_bf16(acc[nt][2], acc[nt + 4][2]); w.w = cvt_pk_bf16(acc[nt][3], acc[nt + 4][3]);
        *(u32x4*)(Sg + (size_t)chunk * 64 + nt * 16 + q * 4) = w; }
}
__device__ __forceinline__ void ssm_y_tile(const u32x4 (&raw)[8], const float (&g8)[8], const unsigned* Hg, int mt, int fr, int q, const LAS float* RS, const LAS bf16_t* KT, const LAS unsigned char* ET, bf16_t* Yg) {
    const int chunk = mt * 16 + fr; const bool valid = chunk < NCHUNK;
    u32x4 hw[4]; ssm_load_h(Hg, mt, fr, q, hw);
    f32x4 acc[16];
#pragma unroll
    for (int i = 0; i < 16; ++i) acc[i] = (f32x4){0.f, 0.f, 0.f, 0.f};
#pragma unroll
    for (int ks = 0; ks < 8; ++ks) {
        const int s = 2 * ks + (q >> 1), c0 = (q & 1) * 8;
        const bf16x8 af = ssm_scale(raw[ks], valid ? RS[chunk * 16 + s] : 0.f, g8);
#pragma unroll
        for (int j = 2 * ks; j < 16; ++j) {
            const int d = j - s;
            u32x4 bw = *(const LAS u32x4*)(KT + ((d < 0 ? 0 : d) * 256 + fr * 16 + c0));
            if (d < 0) bw = (u32x4){0u, 0u, 0u, 0u};
            acc[j] = __builtin_amdgcn_mfma_f32_16x16x32_bf16(__builtin_bit_cast(bf16x8, bw), af, acc[j], 0, 0, 0);
            if ((j & 3) == 3) __builtin_amdgcn_sched_barrier(0);
        }
    }
#pragma unroll
    for (int kh = 0; kh < 4; ++kh) {
        const bf16x8 af = __builtin_bit_cast(bf16x8, hw[kh]);
#pragma unroll
        for (int j = 0; j < 16; ++j) { const bf16x8 bfr = *(const LAS bf16x8*)(ET + (j * 16 + fr) * ET_PITCH + (kh * 32 + q * 8) * 2);
            acc[j] = __builtin_amdgcn_mfma_f32_16x16x32_bf16(bfr, af, acc[j], 0, 0, 0);
            if ((j & 3) == 3) __builtin_amdgcn_sched_barrier(0); }
    }
    if (valid) {
#pragma unroll
        for (int j = 0; j < 16; ++j) { u32x2 o; o.x = cvt_pk_bf16(gelu_tanh(acc[j][0]), gelu_tanh(acc[j][1])); o.y = cvt_pk_bf16(gelu_tanh(acc[j][2]), gelu_tanh(acc[j][3]));
            *(u32x2*)(Yg + ((size_t)chunk * 16 + j) * 16 + q * 4) = o; }
    }
}
__device__ __forceinline__ void ssm_group(Frame& F, const Args& args, int g, const bf16_t* UgAll, bf16_t* YgAll, const float* ss, unsigned* SgAll, unsigned* HgAll) {
    LAS f32x2* AP = (LAS f32x2*)(F.lds + L_AP);
    LAS f32x2* APT = (LAS f32x2*)(F.lds + L_APT);
    LAS f32x2* BB = (LAS f32x2*)(F.lds + L_BB);
    LAS f32x2* CC = (LAS f32x2*)(F.lds + L_CC);
    LAS f32x2* CCT = (LAS f32x2*)(F.lds + L_CCT);
    LAS bf16_t* KT = (LAS bf16_t*)(F.lds + L_KT);
    LAS float* DD = (LAS float*)(F.lds + L_DD);
    LAS f32x2* XW = (LAS f32x2*)(F.lds + L_XW);
    LAS float* RS = (LAS float*)(F.lds + L_RS);
    LAS unsigned char* TAB = F.lds + L_TAB;
    const bf16_t* Ug = UgAll + (size_t)g * MROWS * 16; bf16_t* Yg = YgAll + (size_t)g * MROWS * 16;
    unsigned* Sg = SgAll + (size_t)g * NCHP * 64; unsigned* Hg = HgAll + (size_t)g * NCHP * 64;
    const int tid = F.tid, lane = F.lane, wave = F.wave, fr = lane & 15, q = lane >> 4;
    float g8[8];
#pragma unroll
    for (int i = 0; i < 8; ++i) g8[i] = args.in[5][DM + g * CG + (q & 1) * 8 + i];
    u32x4 ra[8], rb[8];
    if (wave < NCHP / 16) ssm_load_u(Ug, wave, fr, q, ra);
    f32x2 bpar[2];
#pragma unroll
    for (int i = 0; i < 2; ++i) { const int e = tid + i * NWAVES * 64; bpar[i] = (f32x2){args.in[11][(size_t)g * PST * CG + e], args.in[12][(size_t)g * PST * CG + e]}; }
    {
        const float dt = expf(args.in[10][g]);
        for (int e = tid; e < 17 * PST; e += NWAVES * 64) { const int tau = e >> 6, p = e & 63;
            const float are = args.in[8][g * PST + p], aim = args.in[9][g * PST + p];
            double ang = (double)aim * (double)dt * (double)tau; ang -= 6.283185307179586 * floor(ang * 0.15915494309189535);
            float sn, cs; sincosf((float)ang, &sn, &cs); const float mag = expf(are * dt * (float)tau);
            const f32x2 v = (f32x2){mag * cs, mag * sn}; AP[e] = v; APT[p * 17 + tau] = v; }
        if (tid < PST) { const int p = tid;
            const float are = args.in[8][g * PST + p], aim = args.in[9][g * PST + p]; const f32x2 z = (f32x2){are * dt, aim * dt}; f32x2 qv;
            if (z.x * z.x + z.y * z.y < 0.0625f) { f32x2 h = (f32x2){1.f, 0.f};
#pragma unroll
                for (int k = 8; k >= 2; --k) { h = cmul(z, h); h.x = 1.f + h.x * (1.0f / k); h.y = h.y * (1.0f / k); }
                qv = (f32x2){dt * h.x, dt * h.y};
            } else { float sn, cs; sincosf(z.y, &sn, &cs); const float mag = expf(z.x); const float nr = mag * cs - 1.0f, ni = mag * sn, den = 1.0f / (are * are + aim * aim);
                qv = (f32x2){(nr * are + ni * aim) * den, (ni * are - nr * aim) * den}; }
            XW[p] = qv; }
        for (int e = tid; e < CG * PST; e += NWAVES * 64) { const f32x2 v = (f32x2){args.in[13][(size_t)g * CG * PST + e], args.in[14][(size_t)g * CG * PST + e]}; CC[e] = v; CCT[(e & 63) * 16 + (e >> 6)] = v; }
        if (tid < CG) DD[tid] = args.in[15][g * CG + tid];
        for (int e = tid; e < MROWS; e += NWAVES * 64) RS[e] = __builtin_amdgcn_rsqf(ss[e] * (1.0f / DM) + EPS);
        __syncthreads();
#pragma unroll
        for (int i = 0; i < 2; ++i) { const int e = tid + i * NWAVES * 64; BB[e] = cmul(XW[e >> 4], bpar[i]); }
    }
    __syncthreads();
    {
        for (int e = tid; e < 128 * 128; e += NWAVES * 64) {
            const int n = e >> 7, k = (e & 127) * 2, p = n & 63, s = k >> 4, cp = k & 15;
            const f32x2 ap = APT[p * 17 + 15 - s], v0 = cmul(ap, BB[p * 16 + cp]), v1 = cmul(ap, BB[p * 16 + cp + 1]);
            *(LAS unsigned*)(TAB + n * FT_PITCH + k * 2) = (n >> 6) ? pk2(v0.y, v1.y) : pk2(v0.x, v1.x);
        }
    }
    __syncthreads();
    { int mt = wave;
      while (mt < NCHP / 16) {
          const int m2 = mt + NWAVES; if (m2 < NCHP / 16) ssm_load_u(Ug, m2, fr, q, rb);
          ssm_s_tile(ra, g8, mt, fr, q, RS, TAB, Sg);
          mt = m2; if (mt >= NCHP / 16) break;
          const int m3 = mt + NWAVES; if (m3 < NCHP / 16) ssm_load_u(Ug, m3, fr, q, ra);
          ssm_s_tile(rb, g8, mt, fr, q, RS, TAB, Sg);
          mt = m3; } }
    asm volatile("s_waitcnt vmcnt(0)" ::: "memory");
    __syncthreads();
    {
        const f32x2 a16 = AP[16 * 64 + lane];
        const unsigned* Sl = Sg + (size_t)(wave * 64) * 64 + lane;
        unsigned sv[64];
#pragma unroll
        for (int i = 0; i < 64; ++i) sv[i] = __hip_atomic_load(Sl + (size_t)i * 64, RLX_AGENT);
        for (int e = tid; e < 272 * 64; e += NWAVES * 64) {
            const int n = e >> 6, p = e & 63, j = n >> 4, c = n & 15;
            const f32x2 cc = CC[c * 64 + p], z = (j < 16) ? cmul(cc, AP[(j + 1) * 64 + p]) : cc;
            *(LAS unsigned*)(TAB + n * ET_PITCH + p * 4) = pk2(z.x, -z.y);
        }
#pragma unroll
        for (int i = 0; i < 2; ++i) { const int e = tid + i * NWAVES * 64, pp = e >> 4, cp = e & 15; const f32x2 bb = BB[e];
            *(LAS unsigned*)(F.lds + L_APT + cp * ET_PITCH + pp * 4) = pk2(bb.x, bb.y); }
        f32x2 T = (f32x2){0.f, 0.f};
#pragma unroll
        for (int i = 0; i < 64; ++i) { T = cmul(a16, T); T.x += bf_lo(sv[i]); T.y += bf_hi(sv[i]); }
        XW[wave * 64 + lane] = T;
        __syncthreads();
        f32x2 a64 = a16;
#pragma unroll
        for (int i = 0; i < 6; ++i) a64 = cmul(a64, a64);
        f32x2 Hc = (f32x2){0.f, 0.f};
        for (int v = 0; v < wave; ++v) { Hc = cmul(a64, Hc); const f32x2 tv = XW[v * 64 + lane]; Hc.x += tv.x; Hc.y += tv.y; }
        unsigned* Hl = Hg + (size_t)(wave * 64) * 64 + lane;
#pragma unroll
        for (int i = 0; i < 64; ++i) { Hl[(size_t)i * 64] = cvt_pk_bf16(Hc.x, Hc.y); Hc = cmul(a16, Hc); Hc.x += bf_lo(sv[i]); Hc.y += bf_hi(sv[i]); }
        if (wave == NWAVES - 1) { args.out[O_SRP + (size_t)g * PST + lane] = Hc.x; args.out[O_SIP + (size_t)g * PST + lane] = Hc.y; }
        if (wave == 0) {
            f32x2 h0s[NB]; unsigned s0s[NB];
#pragma unroll
            for (int b = 0; b < NB; ++b) { const int c = SEQ / 16 + b;
                h0s[b] = (f32x2){args.in[3][((size_t)b * NGRP + g) * PST + lane], args.in[4][((size_t)b * NGRP + g) * PST + lane]};
                s0s[b] = __hip_atomic_load(Sg + (size_t)c * 64 + lane, RLX_AGENT); }
#pragma unroll
            for (int b = 0; b < NB; ++b) { const int c = SEQ / 16 + b;
                Hg[(size_t)c * 64 + lane] = cvt_pk_bf16(h0s[b].x, h0s[b].y);
                f32x2 ho = cmul(a16, h0s[b]); ho.x += bf_lo(s0s[b]); ho.y += bf_hi(s0s[b]);
                args.out[O_SRS + ((size_t)b * NGRP + g) * PST + lane] = ho.x; args.out[O_SIS + ((size_t)b * NGRP + g) * PST + lane] = ho.y; }
        }
    }
    asm volatile("s_waitcnt vmcnt(0)" ::: "memory");
    __syncthreads();
#pragma unroll
    for (int t2 = 0; t2 < 2; ++t2) { const int tau = wave * 2 + t2, jrow = (tau == 0) ? 16 : tau - 1;
        f32x4 kacc = (f32x4){0.f, 0.f, 0.f, 0.f};
#pragma unroll
        for (int kh = 0; kh < 4; ++kh) {
            const bf16x8 fa = *(const LAS bf16x8*)(F.lds + L_APT + fr * ET_PITCH + (kh * 32 + q * 8) * 2);
            const bf16x8 fb = *(const LAS bf16x8*)(TAB + (jrow * 16 + fr) * ET_PITCH + (kh * 32 + q * 8) * 2);
            kacc = __builtin_amdgcn_mfma_f32_16x16x32_bf16(fa, fb, kacc, 0, 0, 0); }
        const float dd = (tau == 0 && (fr >> 2) == q) ? DD[fr] : 0.f;
        kacc[0] += ((fr & 3) == 0) ? dd : 0.f; kacc[1] += ((fr & 3) == 1) ? dd : 0.f; kacc[2] += ((fr & 3) == 2) ? dd : 0.f; kacc[3] += ((fr & 3) == 3) ? dd : 0.f;
        u32x2 o; o.x = cvt_pk_bf16_c(kacc[0], kacc[1]); o.y = cvt_pk_bf16_c(kacc[2], kacc[3]);
        *(LAS u32x2*)(KT + tau * 256 + fr * 16 + q * 4) = o; }
    __syncthreads();
    { u32x4 ra[8], rb[8]; int mt = wave;
      if (mt < NCHP / 16) ssm_load_u(Ug, mt, fr, q, ra);
      while (mt < NCHP / 16) {
          const int m2 = mt + NWAVES; if (m2 < NCHP / 16) ssm_load_u(Ug, m2, fr, q, rb);
          ssm_y_tile(ra, g8, Hg, mt, fr, q, RS, KT, TAB, Yg);
          mt = m2; if (mt >= NCHP / 16) break;
          const int m3 = mt + NWAVES; if (m3 < NCHP / 16) ssm_load_u(Ug, m3, fr, q, ra);
          ssm_y_tile(rb, g8, Hg, mt, fr, q, RS, KT, TAB, Yg);
          mt = m3; } }
    __syncthreads();
}

template <int MODE>
__device__ __forceinline__ void fixup_rows(Frame& F, const Args& args, unsigned char* ws, const float* ss_in, float* ss_out, const bf16_t* Rin, bf16_t* Aout) {
    const bf16_t* slab = (const bf16_t*)(ws + WS_SLAB);
    LAS float* red = (LAS float*)F.lds;
    constexpr int NSPL = (MODE == 1 || MODE == 2) ? 4 : (MODE == 5 ? 8 : 16), LD = (MODE == 2) ? DFF : (MODE == 5 ? 2 * DM : DM);
    if constexpr (MODE == 2) {
        const float* ssp = ss_in; bf16_t* HB = (bf16_t*)(ws + WS_H);
        for (int it = F.vcu; it < 2 * NSAMP; it += F.G) { const int r = it % NSAMP, sh = it / NSAMP, gr = SEQ + r, c0 = F.tid * 8;
            const float rstd = __builtin_amdgcn_rsqf(ssp[gr] * (1.0f / DM) + EPS);
            u32x4 pw[2][NSPL];
#pragma unroll
            for (int s2 = 0; s2 < 2; ++s2)
#pragma unroll
                for (int sp = 0; sp < NSPL; ++sp) pw[s2][sp] = *(const u32x4*)(slab + ((size_t)sp * NSAMP + r) * LD + (sh * 2 + s2) * DM + c0);
#pragma unroll
            for (int s2 = 0; s2 < 2; ++s2) { const int col = (sh * 2 + s2) * DM + c0;
                f32x4 v0 = (f32x4){0.f, 0.f, 0.f, 0.f}, v1 = v0;
#pragma unroll
                for (int sp = 0; sp < NSPL; ++sp) { const u32x4 q = pw[s2][sp];
                    v0 += (f32x4){bf_lo(q.x), bf_hi(q.x), bf_lo(q.y), bf_hi(q.y)}; v1 += (f32x4){bf_lo(q.z), bf_hi(q.z), bf_lo(q.w), bf_hi(q.w)}; }
#pragma unroll
                for (int j = 0; j < 4; ++j) { const float p0 = fmaxf(v0[j] * rstd, 0.f), p1 = fmaxf(v1[j] * rstd, 0.f); v0[j] = p0 * p0; v1[j] = p1 * p1; }
                u32x4 w; w.x = cvt_pk_bf16(v0[0], v0[1]); w.y = cvt_pk_bf16(v0[2], v0[3]); w.z = cvt_pk_bf16(v1[0], v1[1]); w.w = cvt_pk_bf16(v1[2], v1[3]);
                *(u32x4*)((char*)HB + tiled_off(gr, col, DFF / 64)) = w; }
        }
        return;
    }
    for (int r = F.vcu; r < NSAMP; r += F.G) {
        const int gr = SEQ + r, c0 = F.tid * 8;
        if constexpr (MODE == 2) {
        } else {
            const int scol = (MODE == 5) ? ((c0 >> 7) * 256 + (c0 & 127)) : c0;
            f32x4 v0 = (f32x4){0.f, 0.f, 0.f, 0.f}, v1 = v0, b0 = v0, b1 = v0;
#pragma unroll
            for (int sp = 0; sp < NSPL; ++sp) { const bf16_t* p = slab + ((size_t)sp * NSAMP + r) * LD + scol; const u32x4 pw = *(const u32x4*)p;
                v0 += (f32x4){bf_lo(pw.x), bf_hi(pw.x), bf_lo(pw.y), bf_hi(pw.y)}; v1 += (f32x4){bf_lo(pw.z), bf_hi(pw.z), bf_lo(pw.w), bf_hi(pw.w)};
                if constexpr (MODE == 5) { const u32x4 qw = *(const u32x4*)(p + 128);
                    b0 += (f32x4){bf_lo(qw.x), bf_hi(qw.x), bf_lo(qw.y), bf_hi(qw.y)}; b1 += (f32x4){bf_lo(qw.z), bf_hi(qw.z), bf_lo(qw.w), bf_hi(qw.w)}; } }
            if constexpr (MODE == 1) { const float* xr = args.in[1] + (size_t)r * DM + c0; const float* sc = args.in[7] + c0;
                v0 = *(const f32x4*)xr + *(const f32x4*)sc * v0; v1 = *(const f32x4*)(xr + 4) + *(const f32x4*)(sc + 4) * v1; }
            else { const u32x4 rw = (MODE == 5) ? *(const u32x4*)(Rin + ((size_t)(c0 >> 4) * MROWS + gr) * 16 + (c0 & 15)) : *(const u32x4*)((const char*)Rin + tiled_off(gr, c0, DM / 64));
                if constexpr (MODE == 5) {
#pragma unroll
                    for (int j = 0; j < 4; ++j) { v0[j] *= sigmoidf_(b0[j]); v1[j] *= sigmoidf_(b1[j]); } }
                v0 += (f32x4){bf_lo(rw.x), bf_hi(rw.x), bf_lo(rw.y), bf_hi(rw.y)}; v1 += (f32x4){bf_lo(rw.z), bf_hi(rw.z), bf_lo(rw.w), bf_hi(rw.w)}; }
            float ss = (v0[0] * v0[0] + v0[1] * v0[1]) + (v0[2] * v0[2] + v0[3] * v0[3]) + (v1[0] * v1[0] + v1[1] * v1[1]) + (v1[2] * v1[2] + v1[3] * v1[3]);
            ss = wave_sum(ss); if (F.lane == 0) red[F.wave] = ss;
            __syncthreads();
            ss = ((red[0] + red[1]) + (red[2] + red[3])) + ((red[4] + red[5]) + (red[6] + red[7]));
            __syncthreads();
            if constexpr (MODE == 7) {
                const float rstd = 1.0f / sqrtf(ss * (1.0f / DM) + EPS); const float* gf = args.in[21] + c0; float* yo = args.out + O_YP + (size_t)gr * DM + c0;
                *(f32x4*)yo = v0 * rstd * *(const f32x4*)gf; *(f32x4*)(yo + 4) = v1 * rstd * *(const f32x4*)(gf + 4);
            } else {
                if (F.tid == 0) ss_out[gr] = ss;
                u32x4 w; w.x = cvt_pk_bf16(v0[0], v0[1]); w.y = cvt_pk_bf16(v0[2], v0[3]); w.z = cvt_pk_bf16(v1[0], v1[1]); w.w = cvt_pk_bf16(v1[2], v1[3]);
                if constexpr (MODE == 3) *(u32x4*)(Aout + ((size_t)(c0 >> 4) * MROWS + gr) * 16 + (c0 & 15)) = w;
                else *(u32x4*)((char*)Aout + tiled_off(gr, c0, DM / 64)) = w;
            }
        }
    }
}

__global__ void __launch_bounds__(NWAVES * 64, 2) trunk_fwd(Args args) {
    extern __shared__ __attribute__((aligned(16))) unsigned char lds[];
    Frame F;
    F.lds = (LAS unsigned char*)lds;
    F.tid = threadIdx.x; F.lane = F.tid & 63; F.wave = __builtin_amdgcn_readfirstlane(F.tid >> 6);
    F.G = gridDim.x; { const int bx = blockIdx.x; F.vcu = (F.G % 8 == 0) ? (bx % 8) * (F.G / 8) + bx / 8 : bx; }
    volatile LAS unsigned* MISC = (volatile LAS unsigned*)(F.lds + MISC_OFF);
    unsigned char* ws = args.ws;
    unsigned* ctl = (unsigned*)(ws + WS_CTL);
    for (int u = F.tid; u < 512 / 4; u += NWAVES * 64) ((LAS unsigned*)(F.lds + LDSCTL_OFF))[u] = 0u;
    __syncthreads();
    XcdBarrier bar; bar.bar = ctl + CW_BAR; bar.x = 0; bar.st = nullptr;
    if (N_LAUNCHES == 1) bar = xcd_barrier_post(ctl + CW_BAR, MISC + 8);
#define GRID_BAR() do { if (N_LAUNCHES == 1) xcd_barrier(bar); } while (0)
    const int lo = args.ph_lo, hi = args.ph_hi;
#define IN(k) (lo <= (k) && (k) < hi)
    bf16_t* WPOOL = (bf16_t*)(ws + WS_WPOOL); bf16_t* WGLU = (bf16_t*)(ws + WS_WGLU);
    bf16_t* WUP0 = (bf16_t*)(ws + WS_WUP0); bf16_t* WUP1 = (bf16_t*)(ws + WS_WUP1); bf16_t* WDN0 = (bf16_t*)(ws + WS_WDN0); bf16_t* WDN1 = (bf16_t*)(ws + WS_WDN1);
    bf16_t* A2 = (bf16_t*)(ws + WS_X); bf16_t* A0 = (bf16_t*)(ws + WS_A0); bf16_t* A1 = (bf16_t*)(ws + WS_A1); bf16_t* HB = (bf16_t*)(ws + WS_H);
    bf16_t* SLAB = (bf16_t*)(ws + WS_SLAB); float* SS1 = (float*)(ws + WS_SS); float* SS2 = SS1 + MROWS; float* SS3 = SS2 + MROWS; float* SS4 = SS3 + MROWS;

    if (IN(0)) {
        constexpr int T_POOL = 4 * 8 * 8, T_UP = 32 * 128, T_DN = 128 * 32, T_GLU = 32 * 32;
        constexpr int NT_ALL = T_POOL + 2 * T_UP + 2 * T_DN + 2 * T_GLU;
#define T0_DESC(it_, T) do { int r = (it_); \
            if (r < T_POOL) { const int gi = r >> 6, kb = (r >> 3) & 7, nb = r & 7; T = T0Tile{args.in[6] + (size_t)gi * 1024 * 1024, 1024, 1024, nullptr, WPOOL, gi * 1024 + nb * 128, kb * 128, nb * 128}; break; } r -= T_POOL; \
            if (r < 2 * T_UP) { const int l = r / T_UP, rr = r % T_UP, kb = rr >> 7, nb = rr & 127; T = T0Tile{args.in[19] + (size_t)l * DM * DFF, DM, DFF, args.in[18] + l * DM, l ? WUP1 : WUP0, nb * 128, kb * 128, nb * 128}; break; } r -= 2 * T_UP; \
            if (r < 2 * T_DN) { const int l = r / T_DN, rr = r % T_DN, kb = rr >> 5, nb = rr & 31; T = T0Tile{args.in[20] + (size_t)l * DFF * DM, DFF, DM, nullptr, l ? WDN1 : WDN0, nb * 128, kb * 128, nb * 128}; break; } r -= 2 * T_DN; \
            { const int ab = r / T_GLU, rr = r % T_GLU, kb = rr >> 5, nb = rr & 31; T = T0Tile{args.in[ab ? 17 : 16], DM, DM, nullptr, WGLU, nb * 256 + ab * 128, kb * 128, nb * 128}; } } while (0)
        {
            unsigned* qctr = ctl + CW_Q0; volatile LAS unsigned* qw = MISC + 40;
            constexpr unsigned QEND = (unsigned)(NCHUNK + NT_ALL);
            unsigned pend = 0u;
            if (F.tid == 0) pend = q_grab(qctr);
            unsigned a = q_next(F, qw, qctr, pend), b = q_next(F, qw, qctr, pend);
            while (a < (unsigned)NCHUNK) { t1_unit(F, args, (int)a, A0); a = b; b = q_next(F, qw, qctr, pend); }
            float va[16][2], vb[16][2]; T0Tile ta, tb;
            if (a < QEND) { T0_DESC((int)a - NCHUNK, ta); t0_load(F, ta, va); }
            while (a < QEND) {
                if (b < QEND) { T0_DESC((int)b - NCHUNK, tb); t0_load(F, tb, vb); }
                const unsigned c = t0_store(F, ta, va, qw, qctr, pend);
                if (b >= QEND) break;
                if (c < QEND) { T0_DESC((int)c - NCHUNK, ta); t0_load(F, ta, va); }
                const unsigned d = t0_store(F, tb, vb, qw, qctr, pend);
                a = c; b = d;
            }
        }
#undef T0_DESC
        if (IN(1)) GRID_BAR();
    }
    if (IN(1)) {
        pg8::Gemm g{(const char*)A0, (const char*)WPOOL, DM * 2u, 32u, 1024 * 2u, 16, 4, 64, 0u};
        pg8::Sched S; S.init(16, F.G, (int)blockIdx.x, 4);
        Epi<1> E{{args.in[0], args.in[1], nullptr, A1, nullptr, nullptr, args.in[7], nullptr, SS1, SLAB, DM}};
        pg8::gemm_phase(F.lds, g, S, E);
        if (IN(2)) GRID_BAR();
    }
    if (IN(2)) { fixup_rows<1>(F, args, ws, nullptr, SS1, nullptr, A1); if (IN(3)) GRID_BAR(); }
    if (IN(3)) {
        pg8::Gemm g{(const char*)A1, (const char*)WUP0, 0u, 8192u, DM * 2u, 64, 16, 0, (DM / 64) * 32768u};
        pg8::Sched S; S.init(64, F.G, (int)blockIdx.x, 4);
        Epi<2> E{{nullptr, nullptr, nullptr, nullptr, HB, nullptr, nullptr, SS1, nullptr, SLAB, DFF}};
        pg8::gemm_phase(F.lds, g, S, E);
#if REP_UP > 1
        __syncthreads();
        pg8::gemm_phase(F.lds, g, S, E);
#endif
        if (IN(4)) GRID_BAR();
    }
    if (IN(4)) { fixup_rows<2>(F, args, ws, SS1, nullptr, nullptr, nullptr); if (IN(5)) GRID_BAR(); }
    if (IN(5)) {
        pg8::Gemm g{(const char*)HB, (const char*)WDN0, 0u, 8192u, DFF * 2u, 256, 16, 0, (DFF / 64) * 32768u};
        pg8::Sched S; S.init(16, F.G, (int)blockIdx.x, 16);
        Epi<3> E{{nullptr, nullptr, A1, A0, nullptr, nullptr, nullptr, nullptr, SS2, SLAB, DM}};
        pg8::gemm_phase(F.lds, g, S, E);
        if (IN(6)) GRID_BAR();
    }
    if (IN(6)) { fixup_rows<3>(F, args, ws, nullptr, SS2, A1, A0); if (IN(7)) GRID_BAR(); }
    if (IN(7)) {
        for (int g = F.vcu; g < NGRP; g += F.G) ssm_group(F, args, g, A0, A1, SS2, (unsigned*)(ws + WS_SG), (unsigned*)(ws + WS_HG));
#if REP_SSM > 1
        for (int g = F.vcu; g < NGRP; g += F.G) ssm_group(F, args, g, A0, A1, SS2, (unsigned*)(ws + WS_SG), (unsigned*)(ws + WS_HG));
#endif
        if (IN(8)) GRID_BAR();
    }
    if (IN(8)) {
        pg8::Gemm g{(const char*)A1, (const char*)WGLU, 32u, (unsigned)MROWS * 32u, DM * 2u, 64, 8, 0, 0u};
        pg8::Sched S; S.init(32, F.G, (int)blockIdx.x, 8);
        Epi<4> E{{nullptr, nullptr, A0, A2, nullptr, nullptr, nullptr, nullptr, SS3, SLAB, 2 * DM}};
        pg8::gemm_phase(F.lds, g, S, E);
        if (IN(9)) GRID_BAR();
    }
    if (IN(9)) { fixup_rows<5>(F, args, ws, nullptr, SS3, A0, A2); if (IN(10)) GRID_BAR(); }
    if (IN(10)) {
        pg8::Gemm g{(const char*)A2, (const char*)WUP1, 0u, 8192u, DM * 2u, 64, 16, 0, (DM / 64) * 32768u};
        pg8::Sched S; S.init(64, F.G, (int)blockIdx.x, 4);
        Epi<2> E{{nullptr, nullptr, nullptr, nullptr, HB, nullptr, nullptr, SS3, nullptr, SLAB, DFF}};
        pg8::gemm_phase(F.lds, g, S, E);
        if (IN(11)) GRID_BAR();
    }
    if (IN(11)) { fixup_rows<2>(F, args, ws, SS3, nullptr, nullptr, nullptr); if (IN(12)) GRID_BAR(); }
    if (IN(12)) {
        pg8::Gemm g{(const char*)HB, (const char*)WDN1, 0u, 8192u, DFF * 2u, 256, 16, 0, (DFF / 64) * 32768u};
        pg8::Sched S; S.init(16, F.G, (int)blockIdx.x, 16);
        Epi<5> E{{nullptr, nullptr, A2, A1, nullptr, nullptr, nullptr, nullptr, SS4, SLAB, DM}};
        pg8::gemm_phase(F.lds, g, S, E);
        if (IN(13)) GRID_BAR();
    }
    if (IN(13)) {
        fixup_rows<7>(F, args, ws, nullptr, nullptr, A2, nullptr);
        const float* gf = args.in[21];
        const int gw = F.vcu * NWAVES + F.wave, NGW = F.G * NWAVES;
        for (int m = gw; m < SEQ; m += NGW) {
            float* row = args.out + O_YP + (size_t)m * DM + F.lane * 8; const bf16_t* xr = A1 + (size_t)m * DM + F.lane * 8;
            const float r = 1.0f / sqrtf(SS4[m] * (1.0f / DM) + EPS);
#pragma unroll 4
            for (int j = 0; j < 8; ++j) { const u32x4 w = *(const u32x4*)(xr + j * 512); const f32x4 g0 = *(const f32x4*)(gf + j * 512 + F.lane * 8), g1 = *(const f32x4*)(gf + j * 512 + F.lane * 8 + 4);
                *(f32x4*)(row + j * 512) = (f32x4){bf_lo(w.x), bf_hi(w.x), bf_lo(w.y), bf_hi(w.y)} * r * g0; *(f32x4*)(row + j * 512 + 4) = (f32x4){bf_lo(w.z), bf_hi(w.z), bf_lo(w.w), bf_hi(w.w)} * r * g1; }
        }
    }
#undef IN
#undef GRID_BAR
}

extern "C" void kernel_launch(void* const* d_in, const int* in_sizes, int n_in, void* d_out, int out_size, void* d_ws, size_t ws_size, hipStream_t stream) {
    static int grid = 0;
    if (grid == 0) {
        if (n_in != 22 || in_sizes[0] != SEQ * DM || (size_t)out_size != O_END || ws_size < WS_END) {
            fprintf(stderr, "kernel_launch: unexpected shapes (n_in %d, in0 %d, out %d, ws %zu); nothing launched\n", n_in, n_in > 0 ? in_sizes[0] : -1, out_size, ws_size); grid = -1; return; }
        int dev = 0, cus = 0, per_cu = 0;
        if (hipGetDevice(&dev) != hipSuccess || hipDeviceGetAttribute(&cus, hipDeviceAttributeMultiprocessorCount, dev) != hipSuccess) { fprintf(stderr, "kernel_launch: device query failed\n"); grid = -1; return; }
        if (hipFuncSetAttribute((const void*)trunk_fwd, hipFuncAttributeMaxDynamicSharedMemorySize, LDS_BYTES) != hipSuccess) { fprintf(stderr, "kernel_launch: hipFuncSetAttribute failed\n"); grid = -1; return; }
        if (hipOccupancyMaxActiveBlocksPerMultiprocessor(&per_cu, (const void*)trunk_fwd, NWAVES * 64, LDS_BYTES) != hipSuccess || per_cu < 1)
            fprintf(stderr, "kernel_launch: note: occupancy query reports %d workgroups per CU\n", per_cu);
        (void)hipGetLastError();
        grid = cus;
    }
    if (grid < 0) return;
    if (hipMemsetAsync((char*)d_ws + WS_CTL, 0, CTL_ZERO_BYTES, stream) != hipSuccess) { fprintf(stderr, "kernel_launch: memset failed\n"); return; }
    Args a{};
    for (int i = 0; i < 22; ++i) a.in[i] = (const float*)d_in[i];
    a.out = (float*)d_out; a.ws = (unsigned char*)d_ws;
    for (int li = 0; li < N_LAUNCHES; ++li) {
        a.ph_lo = (N_LAUNCHES == 1) ? 0 : li; a.ph_hi = (N_LAUNCHES == 1) ? NPHASE : li + 1;
        hipLaunchKernelGGL(trunk_fwd, dim3(grid), dim3(NWAVES * 64), LDS_BYTES, stream, a);
        const hipError_t le = hipPeekAtLastError();
        if (le != hipSuccess) { fprintf(stderr, "kernel_launch: launch %d failed: %s\n", li, hipGetErrorName(le)); break; }
    }
}
```
